# Optimizing an MI355X kernel written in HIP

```python
import math
import jax, jax.numpy as jnp
from jax import lax
import numpy as np


D_MODEL = 2048
BATCH = 4
SEQ = 8192
DEPTH = 1

GRID_W = 64
CTX_LEN = 256
N_HEADS_A = 8
HEAD_DIM_A = 64
V_DIM_A = 2 * HEAD_DIM_A
QK_WIDTH_A = N_HEADS_A * 2 * HEAD_DIM_A
WIDTH_A = N_HEADS_A * V_DIM_A
N_HEADS_B = 8
HEAD_DIM_B = 128
WIDTH_B = N_HEADS_B * HEAD_DIM_B
WIN_H = 8
WIN_W = 16
N_EXPERTS = 16
EXPERT_FF = 2048
CAPACITY_FACTOR = 2
Q_BLOCK = 128
ROPE_BASE = 10000.0
EPS = 1e-6
NEG_INF = -1e30

OFF_QA = 0
OFF_QB = OFF_QA + QK_WIDTH_A
OFF_GATE = OFF_QB + WIDTH_B
OFF_KA = OFF_GATE + 2 * D_MODEL
OFF_VA = OFF_KA + QK_WIDTH_A
OFF_KB = OFF_VA + WIDTH_A
OFF_VB = OFF_KB + WIDTH_B
PROJ_DIM = OFF_VB + WIDTH_B

kernel_name = 'hybrid_diffattn_natten_ecmoe_dit_block'


def rms_norm(x, g):
    xf = x.astype(jnp.float32)
    y = xf * lax.rsqrt(jnp.mean(xf * xf, axis=-1, keepdims=True) + EPS)
    return (y * g.astype(jnp.float32)).astype(x.dtype)


def modulate(x, shift, scale):
    return x * (1.0 + scale) + shift


def heads(t, n_heads):
    b, n, _ = t.shape
    return t.reshape(b, n, n_heads, -1).transpose(0, 2, 1, 3)


def merge_heads(t):
    b, h, n, dh = t.shape
    return t.transpose(0, 2, 1, 3).reshape(b, n, h * dh)


def axial_rope_tables(n_tokens):
    t = jnp.arange(n_tokens, dtype=jnp.int32)
    row = (t // GRID_W).astype(jnp.float32)
    col = (t % GRID_W).astype(jnp.float32)
    half = HEAD_DIM_A // 2
    inv_freq = ROPE_BASE ** (-jnp.arange(0, half, 2, dtype=jnp.float32) / half)

    def tab(pos):
        ang = pos[:, None] * inv_freq[None, :]
        ang = jnp.concatenate([ang, ang], axis=-1)
        return jnp.cos(ang), jnp.sin(ang)

    cr, sr = tab(row)
    cc, sc = tab(col)
    return jnp.concatenate([cr, cc], axis=-1), jnp.concatenate([sr, sc], axis=-1)


def rotate_half(x):
    x1, x2 = jnp.split(x, 2, axis=-1)
    return jnp.concatenate([-x2, x1], axis=-1)


def apply_axial_rope(x, cos, sin):
    xr, xc = jnp.split(x, 2, axis=-1)
    rot = jnp.concatenate([rotate_half(xr), rotate_half(xc)], axis=-1)
    return (x * cos + rot * sin).astype(x.dtype)


def split_kv(t):
    k_a = heads(t[..., 0:OFF_VA - OFF_KA], N_HEADS_A)
    v_a = heads(t[..., OFF_VA - OFF_KA:OFF_KB - OFF_KA], N_HEADS_A)
    k_b = heads(t[..., OFF_KB - OFF_KA:OFF_VB - OFF_KA], N_HEADS_B)
    v_b = heads(t[..., OFF_VB - OFF_KA:PROJ_DIM - OFF_KA], N_HEADS_B)
    return k_a, v_a, k_b, v_b


def diff_pair(t, gain):
    return rms_norm(t[..., :HEAD_DIM_A], gain), rms_norm(t[..., HEAD_DIM_A:], gain)


def diff_attend(q1, q2, k1, k2, v, lam):
    scale = HEAD_DIM_A ** -0.5
    p1 = jax.nn.softmax(jnp.einsum('bhqd,bhkd->bhqk', q1, k1).astype(jnp.float32) * scale, axis=-1)
    p2 = jax.nn.softmax(jnp.einsum('bhqd,bhkd->bhqk', q2, k2).astype(jnp.float32) * scale, axis=-1)
    att = (p1 - lam * p2).astype(v.dtype)
    return jnp.einsum('bhqk,bhkd->bhqd', att, v)


def diff_attention_blocks(q1, q2, k1_all, k2_all, v_all, lam):
    b, h, s, d = q1.shape
    nb = s // Q_BLOCK

    def blk(a):
        return a.reshape(b, h, nb, Q_BLOCK, d).transpose(2, 0, 1, 3, 4)

    out = lax.map(lambda qs: diff_attend(qs[0], qs[1], k1_all, k2_all, v_all, lam), (blk(q1), blk(q2)))
    return out.transpose(1, 2, 0, 3, 4).reshape(b, h, s, -1)


def dense_attend(q, k, v):
    scale = q.shape[-1] ** -0.5
    p = jax.nn.softmax(jnp.einsum('bhqd,bhkd->bhqk', q, k).astype(jnp.float32) * scale, axis=-1)
    return jnp.einsum('bhqk,bhkd->bhqd', p.astype(v.dtype), v)


def neighbourhood_attention(q, k, v, k_ctx, v_ctx, rpb, rows):
    b, h, s, dh = q.shape
    n_ctx = k_ctx.shape[2]
    kh = min(WIN_H, rows)
    k_grid = k.reshape(b, h, rows, GRID_W, dh)
    v_grid = v.reshape(b, h, rows, GRID_W, dh)
    q_rows = q.reshape(b, h, rows, GRID_W, dh).transpose(2, 0, 1, 3, 4)
    col = jnp.arange(GRID_W, dtype=jnp.int32)
    col_start = jnp.clip(col - WIN_W // 2, 0, GRID_W - WIN_W)
    in_win = (col[None, :] >= col_start[:, None]) & (col[None, :] < col_start[:, None] + WIN_W)
    col_mask = jnp.tile(in_win, (1, kh))
    idx_c = jnp.clip(col[None, :] - col[:, None] + WIN_W - 1, 0, 2 * WIN_W - 2)
    scale = dh ** -0.5

    def row_step(args):
        r, q_r = args
        r_start = jnp.clip(r - kh // 2, 0, rows - kh)
        k_blk = lax.dynamic_slice_in_dim(k_grid, r_start, kh, axis=2).reshape(b, h, kh * GRID_W, dh)
        v_blk = lax.dynamic_slice_in_dim(v_grid, r_start, kh, axis=2).reshape(b, h, kh * GRID_W, dh)
        idx_r = r_start + jnp.arange(kh, dtype=jnp.int32) - r + WIN_H - 1
        bias = rpb[:, idx_r[:, None, None], idx_c[None, :, :]]
        bias = bias.transpose(0, 2, 1, 3).reshape(h, GRID_W, kh * GRID_W).astype(jnp.float32)
        s_lat = jnp.einsum('bhqd,bhkd->bhqk', q_r, k_blk).astype(jnp.float32) * scale + bias[None]
        s_lat = jnp.where(col_mask, s_lat, NEG_INF)
        s_ctx = jnp.einsum('bhqd,bhkd->bhqk', q_r, k_ctx).astype(jnp.float32) * scale
        p = jax.nn.softmax(jnp.concatenate([s_ctx, s_lat], axis=-1), axis=-1).astype(v.dtype)
        return (jnp.einsum('bhqk,bhkd->bhqd', p[..., :n_ctx], v_ctx)
                + jnp.einsum('bhqk,bhkd->bhqd', p[..., n_ctx:], v_blk))

    out = lax.map(row_step, (jnp.arange(rows, dtype=jnp.int32), q_rows))
    return out.transpose(1, 2, 0, 3, 4).reshape(b, h, s, dh)


def gated_merge(gate_logits, y_a, y_b, w_a, w_b, w_o):
    g_a = jax.nn.sigmoid(gate_logits[..., :D_MODEL])
    g_b = jax.nn.sigmoid(gate_logits[..., D_MODEL:])
    return (g_a * (y_a @ w_a) + g_b * (y_b @ w_b)) @ w_o


def expert_choice_ffn(h, w_router, w_gate, w_up, w_down):
    b, n, d = h.shape
    cap = CAPACITY_FACTOR * n // N_EXPERTS
    aff = jax.nn.softmax((h @ w_router).astype(jnp.float32), axis=-1)
    g, idx = lax.top_k(aff.transpose(0, 2, 1), cap)
    xe = jax.vmap(lambda hb, ib: hb[ib])(h, idx)
    a = jnp.einsum('becd,edf->becf', xe, w_gate)
    u = jnp.einsum('becd,edf->becf', xe, w_up)
    y = jnp.einsum('becf,efd->becd', jax.nn.silu(a) * u, w_down)
    y = y * g[..., None].astype(y.dtype)

    def combine(yb, ib):
        return jnp.zeros((n, d), h.dtype).at[ib.reshape(-1)].add(yb.reshape(-1, d))

    return jax.vmap(combine)(y, idx)


def setup_inputs(seed: int = 0) -> dict:
    key = jax.random.key(seed)
    ks = jax.random.split(key, 32)
    d = D_MODEL

    def nrm(k, shape, scale):
        return jax.random.normal(k, shape, jnp.float32) * scale

    return {
        'x': nrm(ks[0], (BATCH, SEQ, d), 1.0),
        'c': nrm(ks[1], (BATCH, d), 1.0),
        'ctx': nrm(ks[2], (BATCH, CTX_LEN, d), 1.0),
        'c_ctx': nrm(ks[3], (d,), 1.0),
        'w_mod': nrm(ks[4], (DEPTH, d, 6 * d), 0.5 * d ** -0.5),
        'b_mod': nrm(ks[5], (DEPTH, 6 * d), 0.02),
        'g_norm1': 1.0 + nrm(ks[6], (DEPTH, d), 0.05),
        'g_norm2': 1.0 + nrm(ks[7], (DEPTH, d), 0.05),
        'w_in': nrm(ks[8], (DEPTH, d, PROJ_DIM), d ** -0.5),
        'q_gain_a': 1.0 + nrm(ks[9], (DEPTH, HEAD_DIM_A), 0.05),
        'k_gain_a': 1.0 + nrm(ks[10], (DEPTH, HEAD_DIM_A), 0.05),
        'lam_q1': nrm(ks[11], (DEPTH, HEAD_DIM_A), 0.1),
        'lam_k1': nrm(ks[12], (DEPTH, HEAD_DIM_A), 0.1),
        'lam_q2': nrm(ks[13], (DEPTH, HEAD_DIM_A), 0.1),
        'lam_k2': nrm(ks[14], (DEPTH, HEAD_DIM_A), 0.1),
        'subln_gain': 1.0 + nrm(ks[15], (DEPTH, V_DIM_A), 0.05),
        'q_gain_b': 1.0 + nrm(ks[16], (DEPTH, HEAD_DIM_B), 0.05),
        'k_gain_b': 1.0 + nrm(ks[17], (DEPTH, HEAD_DIM_B), 0.05),
        'rel_pos_bias': nrm(ks[18], (DEPTH, N_HEADS_B, 2 * WIN_H - 1, 2 * WIN_W - 1), 0.1),
        'w_branch_a': nrm(ks[19], (DEPTH, WIDTH_A, d), WIDTH_A ** -0.5),
        'w_branch_b': nrm(ks[20], (DEPTH, WIDTH_B, d), WIDTH_B ** -0.5),
        'w_out': nrm(ks[21], (DEPTH, d, d), d ** -0.5),
        'w_router': nrm(ks[22], (DEPTH, d, N_EXPERTS), d ** -0.5),
        'w_exp_gate': nrm(ks[23], (DEPTH, N_EXPERTS, d, EXPERT_FF), d ** -0.5),
        'w_exp_up': nrm(ks[24], (DEPTH, N_EXPERTS, d, EXPERT_FF), d ** -0.5),
        'w_exp_down': nrm(ks[25], (DEPTH, N_EXPERTS, EXPERT_FF, d), EXPERT_FF ** -0.5),
    }


def reference(x, c, ctx, c_ctx, w_mod, b_mod, g_norm1, g_norm2, w_in, q_gain_a, k_gain_a,
              lam_q1, lam_k1, lam_q2, lam_k2, subln_gain, q_gain_b, k_gain_b, rel_pos_bias,
              w_branch_a, w_branch_b, w_out, w_router, w_exp_gate, w_exp_up, w_exp_down):
    s = x.shape[1]
    rows = s // GRID_W
    cos, sin = axial_rope_tables(s)
    for l in range(DEPTH):
        update_ctx = l < DEPTH - 1
        lam_init = 0.8 - 0.6 * math.exp(-0.3 * l)
        lam = (jnp.exp(jnp.sum(lam_q1[l].astype(jnp.float32) * lam_k1[l].astype(jnp.float32)))
               - jnp.exp(jnp.sum(lam_q2[l].astype(jnp.float32) * lam_k2[l].astype(jnp.float32)))
               + lam_init)

        mod = jax.nn.silu(c) @ w_mod[l] + b_mod[l]
        mod_c = jax.nn.silu(c_ctx) @ w_mod[l] + b_mod[l]
        sh1, sc1, ga1, sh2, sc2, ga2 = jnp.split(mod[:, None, :], 6, axis=-1)
        csh1, csc1, cga1, csh2, csc2, cga2 = jnp.split(mod_c, 6, axis=-1)

        h = modulate(rms_norm(x, g_norm1[l]), sh1, sc1)
        hc = modulate(rms_norm(ctx, g_norm1[l]), csh1, csc1)
        proj = h @ w_in[l]
        if update_ctx:
            projc = hc @ w_in[l]
            projc_kv = projc[..., OFF_KA:]
        else:
            projc_kv = hc @ w_in[l][:, OFF_KA:]

        k_a_c, v_a_c, k_b_c, v_b_c = split_kv(projc_kv)
        k1c, k2c = diff_pair(k_a_c, k_gain_a[l])
        k_b_c = rms_norm(k_b_c, k_gain_b[l])

        k_a, v_a, k_b, v_b = split_kv(proj[..., OFF_KA:])
        q1, q2 = diff_pair(heads(proj[..., OFF_QA:OFF_QB], N_HEADS_A), q_gain_a[l])
        q1, q2 = apply_axial_rope(q1, cos, sin), apply_axial_rope(q2, cos, sin)
        k1, k2 = diff_pair(k_a, k_gain_a[l])
        k1, k2 = apply_axial_rope(k1, cos, sin), apply_axial_rope(k2, cos, sin)

        k1_all = jnp.concatenate([k1c, k1], axis=2)
        k2_all = jnp.concatenate([k2c, k2], axis=2)
        v_a_all = jnp.concatenate([v_a_c, v_a], axis=2)
        y_a = diff_attention_blocks(q1, q2, k1_all, k2_all, v_a_all, lam)
        y_a = merge_heads(rms_norm(y_a, subln_gain[l]) * (1.0 - lam_init))

        q_b = rms_norm(heads(proj[..., OFF_QB:OFF_GATE], N_HEADS_B), q_gain_b[l])
        k_b = rms_norm(k_b, k_gain_b[l])
        y_b = merge_heads(neighbourhood_attention(q_b, k_b, v_b, k_b_c, v_b_c, rel_pos_bias[l], rows))

        mix = gated_merge(proj[..., OFF_GATE:OFF_KA], y_a, y_b, w_branch_a[l], w_branch_b[l], w_out[l])
        x_new = x + ga1 * mix
        h2 = modulate(rms_norm(x_new, g_norm2[l]), sh2, sc2)
        x_new = x_new + ga2 * expert_choice_ffn(h2, w_router[l], w_exp_gate[l], w_exp_up[l], w_exp_down[l])

        if update_ctx:
            q1c, q2c = diff_pair(heads(projc[..., OFF_QA:OFF_QB], N_HEADS_A), q_gain_a[l])
            y_a_c = diff_attend(q1c, q2c, k1c, k2c, v_a_c, lam)
            y_a_c = merge_heads(rms_norm(y_a_c, subln_gain[l]) * (1.0 - lam_init))
            q_b_c = rms_norm(heads(projc[..., OFF_QB:OFF_GATE], N_HEADS_B), q_gain_b[l])
            y_b_c = merge_heads(dense_attend(q_b_c, k_b_c, v_b_c))
            mix_c = gated_merge(projc[..., OFF_GATE:OFF_KA], y_a_c, y_b_c, w_branch_a[l], w_branch_b[l], w_out[l])
            ctx_new = ctx + cga1 * mix_c
            h2c = modulate(rms_norm(ctx_new, g_norm2[l]), csh2, csc2)
            ctx = ctx_new + cga2 * expert_choice_ffn(h2c, w_router[l], w_exp_gate[l], w_exp_up[l], w_exp_down[l])
        x = x_new
    return x
```

```cpp
#include <hip/hip_runtime.h>
#include <cstdio>
#include <cstdint>

#ifndef MK_N_LAUNCHES
#define MK_N_LAUNCHES 1
#endif

constexpr int DM = 2048, NB = 4, SEQ = 8192, MTOK = NB * SEQ, CTXL = 256, MCTX = NB * CTXL, MALL = MTOK + MCTX;
constexpr int PROJ = 10240, NE = 16, FF = 2048, CAP = 1024, MSLOT = NB * NE * CAP;
constexpr int GRIDW = 64, GROWS = SEQ / GRIDW;
constexpr float EPS = 1e-6f;
constexpr int UP = DM + 64;
constexpr float LOG2E = 1.4426950408889634f;

namespace pg8 {
#define PG8_LAS __attribute__((address_space(3)))
typedef unsigned short bf16_t;
typedef short bf16x8 __attribute__((ext_vector_type(8)));
typedef float f32x4 __attribute__((ext_vector_type(4)));
typedef unsigned u32x4 __attribute__((ext_vector_type(4)));
typedef unsigned u32x2 __attribute__((ext_vector_type(2)));
constexpr int BM = 256, BK = 64, HALF = 128, HTB = HALF * BK * 2  , STAGE_BYTES = 8 * HTB, NXCD = 8, WGM = 8;

__host__ __device__ __forceinline__ int lds_byte(int r, int c) { const int st = (r >> 4) * 2 + (c >> 5), rr = r & 15, cc = c & 31, ob = rr * 64 + cc * 2; return st * 1024 + (ob ^ (((ob >> 9) & 1) << 5)); }
__host__ __device__ __forceinline__ void stage_rc(int b, int& R, int& C) { const int st = b / 1024, sb = b % 1024, swz = sb ^ (((sb >> 9) & 1) << 5); R = (st >> 1) * 16 + swz / 64; C = (st & 1) * 32 + (swz % 64) / 2; }
__host__ __device__ __forceinline__ int perm32(int rho) { const int n = rho >> 4, i = rho & 15; return 8 * (i >> 2) + 4 * n + (i & 3); }

struct Unit { int pm, pn; };
struct Gemm { const bf16_t* A; const bf16_t* Bt; int M, N, K; int lda = 0; };

struct StaticOrder {
    int nM, nN, nwg, G, c;
    __host__ __device__ void init(int M, int N, int G_, int c_) { nM = M / BM; nN = N / BM; nwg = nM * nN; G = G_; c = c_; }
    __host__ __device__ __forceinline__ bool next(int i, Unit& u) const {
        const long L = (long)i * G + c; if (L >= nwg) return false;
        int wgid = (int)L; { const int q = nwg / NXCD, r = nwg % NXCD, xcd = wgid % NXCD, off = wgid / NXCD; wgid = (xcd < r ? xcd * (q + 1) : r * (q + 1) + (xcd - r) * q) + off; }
        const int nig = WGM * nN, gid = wgid / nig, fm = gid * WGM, gsz = (nM - fm) < WGM ? (nM - fm) : WGM;
        u.pm = fm + ((wgid % nig) % gsz); u.pn = (wgid % nig) / gsz;
        u.pn = (u.pn + (int)(L % NXCD) * nN / NXCD) % nN;
        return true;
    }
    __device__ __forceinline__ void a_ready(const Unit&) const {}
    __device__ __forceinline__ void done(const Unit&) const {}
    __device__ __forceinline__ size_t bofs(const Unit&) const { return 0; }
    static constexpr bool GATHER = false;
};
struct ProjOrder {
    StaticOrder so;
    __device__ void init(int G_, int c_) { so.init(MTOK, PROJ, G_, c_); }
    __device__ bool next(int i, Unit& u) const {
        if (so.next(i, u)) return true;
        const long j = (long)i * so.G + so.c - so.nwg; if (j < 0 || j >= 64) return false;
        u.pm = MTOK / BM + (int)(j >> 4); u.pn = 24 + (int)(j & 15); return true;
    }
    __device__ __forceinline__ void a_ready(const Unit&) const {}
    __device__ __forceinline__ void done(const Unit&) const {}
    __device__ __forceinline__ size_t bofs(const Unit&) const { return 0; }
    static constexpr bool GATHER = false;
};
struct OneUnitOrder {
    StaticOrder so; int which;
    __device__ __forceinline__ bool next(int i, Unit& u) const { return i == 0 && so.next(which, u); }
    __device__ __forceinline__ void a_ready(const Unit&) const {}
    __device__ __forceinline__ void done(const Unit&) const {}
    __device__ __forceinline__ size_t bofs(const Unit&) const { return 0; }
    static constexpr bool GATHER = false;
};
struct ExpertOrder : StaticOrder {
    size_t estride;
    __device__ __forceinline__ size_t bofs(const Unit& u) const { return (size_t)((u.pm >> 2) & 15) * estride; }
};
struct ExpertGatherOrder : ExpertOrder {
    const int* rowmap;
    static constexpr bool GATHER = true;
};

typedef float f32x2_cv __attribute__((ext_vector_type(2))); typedef __bf16 bf16x2_cv __attribute__((ext_vector_type(2)));
__device__ __forceinline__ unsigned cvt_pk_bf16(float lo, float hi) { const f32x2_cv v = {lo, hi}; const bf16x2_cv b = __builtin_convertvector(v, bf16x2_cv); return __builtin_bit_cast(unsigned, b); }
__device__ __forceinline__ float bf_lo(unsigned w) { return __uint_as_float(w << 16); }
__device__ __forceinline__ float bf_hi(unsigned w) { return __uint_as_float(w & 0xffff0000u); }
__device__ __forceinline__ float sigmoidf_(float v) { return __builtin_amdgcn_rcpf(1.0f + __builtin_amdgcn_exp2f(-v * LOG2E)); }


#ifndef FUSE_A
#define FUSE_A 1
#endif
__device__ __forceinline__ size_t gate_off(int pm, int pg, int wave, int lane) { return ((((size_t)pm * 16 + pg) * 8 + wave) * 16) * 512 + (size_t)lane * 8; }
struct EpiProj {
    static constexpr bool PERM = true, AFTER_DRAIN = false, HAS_MID = false;
    bf16_t* pb; size_t pbs; bf16_t* gate;
    PG8_LAS float* X;
    const float* gains; const float* rtab;
    __device__ __forceinline__ void normed(const f32x4 (&acc)[2][2][4][2], const Unit& u, int wr, int wc, int fr, int fq, bf16_t* base, int colt, bool isA, bool isQ) const {
        const int rl0 = wr * 64 + fr;
#pragma unroll
        for (int ai = 0; ai < 2; ++ai)
#pragma unroll
            for (int m = 0; m < 4; ++m)
#pragma unroll
                for (int bj = 0; bj < 2; ++bj) { const f32x4 a0 = acc[ai][bj][m][0], a1 = acc[ai][bj][m][1];
                    float sq = ((a0[0] * a0[0] + a0[1] * a0[1]) + (a0[2] * a0[2] + a0[3] * a0[3])) + ((a1[0] * a1[0] + a1[1] * a1[1]) + (a1[2] * a1[2] + a1[3] * a1[3]));
                    sq += __shfl_xor(sq, 16); sq += __shfl_xor(sq, 32);
                    if (fq == 0) X[((rl0 + ai * HALF + m * 16) * 2 + bj) * 4 + wc] = sq; }
        asm volatile("s_waitcnt lgkmcnt(0)" ::: "memory"); __builtin_amdgcn_s_barrier(); asm volatile("" ::: "memory");
        const float* gain = gains + (isQ ? 0 : 256) + (isA ? 0 : 128);
        const int gd = (isA ? 32 * (wc & 1) : 32 * wc) + 8 * fq;
        const f32x4 g0 = *(const f32x4*)(gain + gd), g1 = *(const f32x4*)(gain + gd + 4);
        const float qs = isQ ? (isA ? 0.125f * LOG2E : 0.08838834764831845f * LOG2E) : 1.0f;
        const int row0 = u.pm * BM + rl0, col0 = colt + wc * 32 + 8 * fq;
        const bool rope = FUSE_A && isA && (u.pm < MTOK / BM);
#pragma unroll
        for (int ai = 0; ai < 2; ++ai)
#pragma unroll
            for (int m = 0; m < 4; ++m) { const int rl = rl0 + ai * HALF + m * 16, row = row0 + ai * HALF + m * 16; bf16_t* rowp = base + (size_t)row * 1024 + col0;
                f32x4 c0 = {1.f, 1.f, 1.f, 1.f}, s0 = {0.f, 0.f, 0.f, 0.f}, c1 = c0, s1 = s0;
                if (rope) { const int t = row % SEQ, pos = (wc & 1) ? (t % GRIDW) : (t / GRIDW); const float* tp = rtab + pos * 32 + 2 * (8 * (fq & 1));
                    const f32x4 t0 = *(const f32x4*)tp, t1 = *(const f32x4*)(tp + 4), t2 = *(const f32x4*)(tp + 8), t3 = *(const f32x4*)(tp + 12);
                    c0 = (f32x4){t0[0], t0[2], t1[0], t1[2]}; s0 = (f32x4){t0[1], t0[3], t1[1], t1[3]}; c1 = (f32x4){t2[0], t2[2], t3[0], t3[2]}; s1 = (f32x4){t2[1], t2[3], t3[1], t3[3]};
                    if (fq < 2) { s0 = -s0; s1 = -s1; } }
#pragma unroll
                for (int bj = 0; bj < 2; ++bj) { const PG8_LAS float* xp = X + (rl * 2 + bj) * 4;
                    const float tot = isA ? (xp[wc & ~1] + xp[wc | 1]) : (((xp[0] + xp[1]) + xp[2]) + xp[3]);
                    const float rstd = __builtin_amdgcn_rsqf(tot * (isA ? (1.0f / 64.0f) : (1.0f / 128.0f)) + EPS);
                    f32x4 v0 = acc[ai][bj][m][0] * rstd * g0, v1 = acc[ai][bj][m][1] * rstd * g1;
                    if (rope) { f32x4 o0, o1;
#pragma unroll
                        for (int e = 0; e < 4; ++e) { o0[e] = __shfl_xor(v0[e], 32); o1[e] = __shfl_xor(v1[e], 32); }
                        v0 = v0 * c0 + o0 * s0; v1 = v1 * c1 + o1 * s1; }
                    v0 = v0 * qs; v1 = v1 * qs;
                    u32x4 w; w.x = cvt_pk_bf16(v0[0], v0[1]); w.y = cvt_pk_bf16(v0[2], v0[3]); w.z = cvt_pk_bf16(v1[0], v1[1]); w.w = cvt_pk_bf16(v1[2], v1[3]);
                    *(u32x4*)(rowp + bj * HALF) = w; } }
    }
    __device__ __forceinline__ void operator()(const f32x4 (&acc)[2][2][4][2], const Unit& u, int wr, int wc, int fr, int fq) const {
        const int pn = u.pn; bf16_t* base; int ldc, colt; bool sig = false;
        if (pn < 8) { base = pb + (size_t)(pn >> 2) * pbs; colt = (pn & 3) * BM; ldc = 1024; }
        else if (pn < 24) { base = gate; colt = (pn - 8) * BM; ldc = 4096; sig = true; }
        else { base = pb + (size_t)(2 + ((pn - 24) >> 2)) * pbs; colt = ((pn - 24) & 3) * BM; ldc = 1024; }
        const bool isB = (pn >= 4 && pn < 8) || (pn >= 32 && pn < 36), isA = FUSE_A && (pn < 4 || (pn >= 24 && pn < 28));
        if (isA || isB) { normed(acc, u, wr, wc, fr, fq, base, colt, isA, pn < 8); return; }
        if (sig) {
            bf16_t* gp = gate + gate_off(u.pm, pn - 8, wr * 4 + wc, (fq << 4) | fr);
#pragma unroll
            for (int ai = 0; ai < 2; ++ai)
#pragma unroll
                for (int m = 0; m < 4; ++m) { f32x4 ra[2], sb[2];
#pragma unroll
                    for (int n = 0; n < 2; ++n)
#pragma unroll
                        for (int e = 0; e < 4; ++e) {
                            const float ea = 1.0f + __builtin_amdgcn_exp2f(fminf(-acc[ai][0][m][n][e] * LOG2E, 50.0f)), eb = 1.0f + __builtin_amdgcn_exp2f(fminf(-acc[ai][1][m][n][e] * LOG2E, 50.0f));
                            const float inv = __builtin_amdgcn_rcpf(ea * eb); sb[n][e] = inv * ea; ra[n][e] = eb * eb * inv; }
                    u32x4 w; w.x = cvt_pk_bf16(ra[0][0], ra[0][1]); w.y = cvt_pk_bf16(ra[0][2], ra[0][3]); w.z = cvt_pk_bf16(ra[1][0], ra[1][1]); w.w = cvt_pk_bf16(ra[1][2], ra[1][3]);
                    *(u32x4*)(gp + (ai * 4 + m) * 512) = w;
                    w.x = cvt_pk_bf16(sb[0][0], sb[0][1]); w.y = cvt_pk_bf16(sb[0][2], sb[0][3]); w.z = cvt_pk_bf16(sb[1][0], sb[1][1]); w.w = cvt_pk_bf16(sb[1][2], sb[1][3]);
                    *(u32x4*)(gp + (8 + ai * 4 + m) * 512) = w; }
            return; }
        const int row0 = u.pm * BM + wr * 64 + fr, col0 = colt + wc * 32 + 8 * fq;
#pragma unroll
        for (int ai = 0; ai < 2; ++ai)
#pragma unroll
            for (int m = 0; m < 4; ++m) { bf16_t* rowp = base + (size_t)(row0 + ai * HALF + m * 16) * ldc + col0;
#pragma unroll
                for (int bj = 0; bj < 2; ++bj) { const f32x4 v0 = acc[ai][bj][m][0], v1 = acc[ai][bj][m][1];
                    u32x4 w; w.x = cvt_pk_bf16(v0[0], v0[1]); w.y = cvt_pk_bf16(v0[2], v0[3]); w.z = cvt_pk_bf16(v1[0], v1[1]); w.w = cvt_pk_bf16(v1[2], v1[3]);
                    *(u32x4*)(rowp + bj * HALF) = w; } }
    }
};
struct EpiMerge {
    static constexpr bool PERM = true, AFTER_DRAIN = false, HAS_MID = true;
    const bf16_t* gate; bf16_t* U;
    __device__ __forceinline__ void mid(f32x4 (&acc)[2][2][4][2], const Unit& u, int wr, int wc, int fr, int fq) const {
        int ln = (fq << 4) | fr; asm volatile("" : "+v"(ln));
        const bf16_t* gp0 = gate + gate_off(u.pm, 2 * u.pn, wr * 4 + wc, ln); const bf16_t* gp1 = gate + gate_off(u.pm, 2 * u.pn + 1, wr * 4 + wc, ln);
        u32x4 r[2][4][2];
#pragma unroll
        for (int ai = 0; ai < 2; ++ai)
#pragma unroll
            for (int m = 0; m < 4; ++m) { r[ai][m][0] = *(const u32x4*)(gp0 + (ai * 4 + m) * 512); r[ai][m][1] = *(const u32x4*)(gp1 + (ai * 4 + m) * 512); }
#pragma unroll
        for (int ai = 0; ai < 2; ++ai)
#pragma unroll
            for (int m = 0; m < 4; ++m)
#pragma unroll
                for (int bj = 0; bj < 2; ++bj) { const u32x4 a = r[ai][m][bj];
                    const f32x4 r0 = {bf_lo(a.x), bf_hi(a.x), bf_lo(a.y), bf_hi(a.y)}, r1 = {bf_lo(a.z), bf_hi(a.z), bf_lo(a.w), bf_hi(a.w)};
                    acc[ai][bj][m][0] *= r0; acc[ai][bj][m][1] *= r1; }
        asm volatile("" ::: "memory");
    }
    __device__ __forceinline__ void operator()(const f32x4 (&acc)[2][2][4][2], const Unit& u, int wr, int wc, int fr, int fq) const {
        int row0 = u.pm * BM + wr * 64 + fr, col0 = u.pn * BM + wc * 32 + 8 * fq; asm volatile("" : "+v"(row0), "+v"(col0));
        u32x4 gb[2][4][2]; const int ln = (fq << 4) | fr;
        const bf16_t* gp0 = gate + gate_off(u.pm, 2 * u.pn, wr * 4 + wc, ln); const bf16_t* gp1 = gate + gate_off(u.pm, 2 * u.pn + 1, wr * 4 + wc, ln);
#pragma unroll
        for (int ai = 0; ai < 2; ++ai)
#pragma unroll
            for (int m = 0; m < 4; ++m) { gb[ai][m][0] = *(const u32x4*)(gp0 + (8 + ai * 4 + m) * 512); gb[ai][m][1] = *(const u32x4*)(gp1 + (8 + ai * 4 + m) * 512); }
#pragma unroll
        for (int ai = 0; ai < 2; ++ai)
#pragma unroll
            for (int m = 0; m < 4; ++m) { bf16_t* op = U + (size_t)(row0 + ai * HALF + m * 16) * UP + col0;
#pragma unroll
                for (int bj = 0; bj < 2; ++bj) { const u32x4 b = gb[ai][m][bj]; const f32x4 v0 = acc[ai][bj][m][0], v1 = acc[ai][bj][m][1];
                    u32x4 w; w.x = cvt_pk_bf16(v0[0] * bf_lo(b.x), v0[1] * bf_hi(b.x)); w.y = cvt_pk_bf16(v0[2] * bf_lo(b.y), v0[3] * bf_hi(b.y));
                    w.z = cvt_pk_bf16(v1[0] * bf_lo(b.z), v1[1] * bf_hi(b.z)); w.w = cvt_pk_bf16(v1[2] * bf_lo(b.w), v1[3] * bf_hi(b.w));
                    *(u32x4*)(op + bj * HALF) = w; } }
    }
};
struct EpiWo {
    static constexpr bool PERM = false, AFTER_DRAIN = false, HAS_MID = false;
    const float* x; const float* mod; float* out; float* rowsq;
    __device__ __forceinline__ void operator()(const f32x4 (&acc)[2][2][4][2], const Unit& u, int wr, int wc, int fr, int fq) const {
        const int b = u.pm >> 5; const float* ga1 = mod + (size_t)b * 12288 + 4096;
        int row0 = u.pm * BM + wr * 64 + fr, col0 = u.pn * BM + wc * 32 + 4 * fq; asm volatile("" : "+v"(row0), "+v"(col0));
        f32x4 gv[2][2];
#pragma unroll
        for (int bj = 0; bj < 2; ++bj)
#pragma unroll
            for (int n = 0; n < 2; ++n) gv[bj][n] = *(const f32x4*)(ga1 + col0 + bj * HALF + n * 16);
#pragma unroll
        for (int ai = 0; ai < 2; ++ai) { f32x4 xv[4][2][2];
#pragma unroll
            for (int m = 0; m < 4; ++m) { const size_t off = (size_t)(row0 + ai * HALF + m * 16) * DM + col0;
#pragma unroll
                for (int bj = 0; bj < 2; ++bj)
#pragma unroll
                    for (int n = 0; n < 2; ++n) xv[m][bj][n] = *(const f32x4*)(x + off + bj * HALF + n * 16); }
#pragma unroll
            for (int m = 0; m < 4; ++m) { const int row = row0 + ai * HALF + m * 16; const size_t off = (size_t)row * DM + col0; float ss = 0.f;
#pragma unroll
                for (int bj = 0; bj < 2; ++bj)
#pragma unroll
                    for (int n = 0; n < 2; ++n) { const f32x4 o = xv[m][bj][n] + gv[bj][n] * acc[ai][bj][m][n];
                        *(f32x4*)(out + off + bj * HALF + n * 16) = o; ss += (o[0] * o[0] + o[1] * o[1]) + (o[2] * o[2] + o[3] * o[3]); }
                ss += __shfl_xor(ss, 16); ss += __shfl_xor(ss, 32);
                if (fq == 0) rowsq[(size_t)row * 32 + u.pn * 4 + wc] = ss; }
            asm volatile("" ::: "memory"); }
    }
};
struct EpiWoDrain {
    static constexpr bool PERM = false, AFTER_DRAIN = true, HAS_MID = false;
    const float* x; const float* mod; float* out; float* rowsq;
    __device__ __forceinline__ void fused(f32x4 (&acc)[2][2][4][2], const Unit& u, int, int, int, int, PG8_LAS unsigned char* lds, int, int) const {
        int t2 = threadIdx.x; asm volatile("" : "+v"(t2));
        const int lane = t2 & 63, fr = lane & 15, fq = lane >> 4, wid = __builtin_amdgcn_readfirstlane(t2 >> 6), wr = wid >> 2, wc = wid & 3;
        const int b = u.pm >> 5; const float* ga1 = mod + (size_t)b * 12288 + 4096;
        const int colg = u.pn * BM;
        constexpr int TS = 1040;
#define EWD_BAR() do { asm volatile("s_waitcnt lgkmcnt(0)" ::: "memory"); __builtin_amdgcn_s_barrier(); asm volatile("" ::: "memory"); } while (0)
#pragma unroll
        for (int ai = 0; ai < 2; ++ai)
#pragma unroll
            for (int wq = 0; wq < 2; ++wq) { const int rbase = u.pm * BM + ai * HALF + wq * 64;
#pragma unroll
                for (int i4 = 0; i4 < 8; i4 += 4) { f32x4 xin[4];
#pragma unroll
                    for (int i = 0; i < 4; ++i) xin[i] = *(const f32x4*)(x + (size_t)(rbase + 8 * wid + i4 + i) * DM + colg + 4 * lane);
#pragma unroll
                    for (int i = 0; i < 4; ++i) *(PG8_LAS f32x4*)(lds + (8 * wid + i4 + i) * TS + lane * 16) = xin[i]; }
                EWD_BAR();
                if (wr == wq) {
                    f32x4 gv[2][2];
#pragma unroll
                    for (int bj = 0; bj < 2; ++bj)
#pragma unroll
                        for (int n = 0; n < 2; ++n) gv[bj][n] = *(const f32x4*)(ga1 + colg + bj * HALF + wc * 32 + n * 16 + 4 * fq);
#pragma unroll
                    for (int m = 0; m < 4; ++m) { const int rq = 16 * m + fr; float ss = 0.f;
#pragma unroll
                        for (int bj = 0; bj < 2; ++bj)
#pragma unroll
                            for (int n = 0; n < 2; ++n) { PG8_LAS f32x4* p = (PG8_LAS f32x4*)(lds + rq * TS + (bj * HALF + wc * 32 + n * 16 + 4 * fq) * 4);
                                const f32x4 o = *p + gv[bj][n] * acc[ai][bj][m][n]; *p = o; ss += (o[0] * o[0] + o[1] * o[1]) + (o[2] * o[2] + o[3] * o[3]); }
                        ss += __shfl_xor(ss, 16); ss += __shfl_xor(ss, 32);
                        if (fq == 0) rowsq[(size_t)(rbase + rq) * 32 + u.pn * 4 + wc] = ss; }
                }
                EWD_BAR();
#pragma unroll
                for (int i = 0; i < 8; ++i) { const f32x4 v = *(const PG8_LAS f32x4*)(lds + (8 * wid + i) * TS + lane * 16); *(f32x4*)(out + (size_t)(rbase + 8 * wid + i) * DM + colg + 4 * lane) = v; }
                EWD_BAR(); }
#undef EWD_BAR
    }
};
struct EpiSwiglu {
    static constexpr bool PERM = true, AFTER_DRAIN = false, HAS_MID = false;
    bf16_t* act;
    __device__ __forceinline__ void operator()(const f32x4 (&acc)[2][2][4][2], const Unit& u, int wr, int wc, int fr, int fq) const {
        const int row0 = u.pm * BM + wr * 64 + fr, col0 = u.pn * HALF + wc * 32 + 8 * fq;
#pragma unroll
        for (int ai = 0; ai < 2; ++ai)
#pragma unroll
            for (int m = 0; m < 4; ++m) { bf16_t* op = act + (size_t)(row0 + ai * HALF + m * 16) * FF + col0; float v[8];
#pragma unroll
                for (int n = 0; n < 2; ++n)
#pragma unroll
                    for (int e = 0; e < 4; ++e) { const float a = acc[ai][0][m][n][e], uu = acc[ai][1][m][n][e]; v[n * 4 + e] = a * sigmoidf_(a) * uu; }
                u32x4 w; w.x = cvt_pk_bf16(v[0], v[1]); w.y = cvt_pk_bf16(v[2], v[3]); w.z = cvt_pk_bf16(v[4], v[5]); w.w = cvt_pk_bf16(v[6], v[7]);
                *(u32x4*)op = w; }
    }
};
struct EpiDown {
    static constexpr bool PERM = true, AFTER_DRAIN = false, HAS_MID = false;
    const float* gsel; const float* mod; bf16_t* ym;
    __device__ __forceinline__ void operator()(const f32x4 (&acc)[2][2][4][2], const Unit& u, int wr, int wc, int fr, int fq) const {
        const int b = u.pm >> 6; const float* ga2 = mod + (size_t)b * 12288 + 10240;
        const int row0 = u.pm * BM + wr * 64 + fr, col0 = u.pn * BM + wc * 32 + 8 * fq;
        f32x4 gv[2][2];
#pragma unroll
        for (int bj = 0; bj < 2; ++bj)
#pragma unroll
            for (int n = 0; n < 2; ++n) gv[bj][n] = *(const f32x4*)(ga2 + col0 + bj * HALF + n * 4);
#pragma unroll
        for (int ai = 0; ai < 2; ++ai)
#pragma unroll
            for (int m = 0; m < 4; ++m) { const int row = row0 + ai * HALF + m * 16; const float gs = gsel[row]; bf16_t* op = ym + (size_t)row * DM + col0;
#pragma unroll
                for (int bj = 0; bj < 2; ++bj) { const f32x4 v0 = acc[ai][bj][m][0] * gv[bj][0] * gs, v1 = acc[ai][bj][m][1] * gv[bj][1] * gs;
                    u32x4 w; w.x = cvt_pk_bf16(v0[0], v0[1]); w.y = cvt_pk_bf16(v0[2], v0[3]); w.z = cvt_pk_bf16(v1[0], v1[1]); w.w = cvt_pk_bf16(v1[2], v1[3]);
                    *(u32x4*)(op + bj * HALF) = w; } }
    }
};

template <class Epi, class Sched, bool ALIGN_EPI = false, bool SP2 = false>
__device__ __forceinline__ void gemm_phase(PG8_LAS unsigned char* lds, const Gemm g, const Sched& S, const Epi& E) {
    const int tid = threadIdx.x, wid = __builtin_amdgcn_readfirstlane(tid >> 6), lane = tid & 63, wr = wid >> 2, wc = wid & 3, fr = lane & 15, fq = lane >> 4;
    const int K = g.K, nt = K / BK, lda = g.lda ? g.lda : K;
    unsigned voffA[2], voffB[2];
#pragma unroll
    for (int i = 0; i < 2; ++i) { int R, C; stage_rc(tid * 16 + i * 8192, R, C); const int Rb = Epi::PERM ? ((R & ~31) + perm32(R & 31)) : R;
        voffA[i] = (unsigned)(R * lda + C) * 2u; voffB[i] = (unsigned)(tid * 16 + i * 8192); (void)Rb; }
    unsigned gc0[2] = {0u, 0u}, gc1[2] = {0u, 0u}, gn0[2] = {0u, 0u}, gn1[2] = {0u, 0u};
#define PG8_GLOOK(u, o0, o1) do { _Pragma("unroll") for (int _i = 0; _i < 2; ++_i) { int R_, C_; stage_rc(tid * 16 + _i * 8192, R_, C_); \
        o0[_i] = (unsigned)S.rowmap[(u).pm * BM + R_] * (unsigned)(K * 2) + (unsigned)(C_ * 2); o1[_i] = (unsigned)S.rowmap[(u).pm * BM + HALF + R_] * (unsigned)(K * 2) + (unsigned)(C_ * 2); } } while (0)
    const size_t kstep = (size_t)(BK * 2);
    const size_t hstep = (size_t)HALF * lda * 2;
    const size_t tstep = 2 * hstep;
    const size_t kstepB = 32768, hstepB = 16384, tstepB = (size_t)nt * 32768;
    const unsigned ldsw = (unsigned)wid * 1024u;
    const int aoff = lds_byte(wr * 64 + fr, fq * 8), boff = lds_byte(wc * 32 + fr, fq * 8);
#define PG8_SA(b, h) (((b) * 2 + (h)) * HTB)
#define PG8_SB(b, h) ((4 + (b) * 2 + (h)) * HTB)
#define PG8_STAGE(bufoff, gbase, voff) do { _Pragma("unroll") for (int _i = 0; _i < 2; ++_i) \
        __builtin_amdgcn_global_load_lds((const unsigned*)((const char*)(gbase) + (voff)[_i]), (PG8_LAS unsigned*)(lds + (bufoff) + ldsw + _i * 8192), 16, 0, 0); } while (0)
#define PG8_STAGE_AC(bufoff, kptr, half) do { if constexpr (Sched::GATHER) { if constexpr ((half) == 0) PG8_STAGE(bufoff, kptr, gc0); else PG8_STAGE(bufoff, kptr, gc1); } else { PG8_STAGE(bufoff, (kptr) + (half) * hstep, voffA); } } while (0)
#define PG8_STAGE_AS(bufoff, kptr, half) do { if constexpr (Sched::GATHER) { if constexpr ((half) == 0) PG8_STAGE(bufoff, kptr, gs0); else PG8_STAGE(bufoff, kptr, gs1); } else { PG8_STAGE(bufoff, (kptr) + (half) * hstep, voffA); } } while (0)
#define PG8_LDA(dst, b, h) do { _Pragma("unroll") for (int m = 0; m < 4; ++m) _Pragma("unroll") for (int k = 0; k < 2; ++k) dst[m][k] = *(const PG8_LAS bf16x8*)(lds + PG8_SA(b, h) + aoff + m * 2048 + k * 1024); } while (0)
#define PG8_LDB(dst, b, h) do { _Pragma("unroll") for (int n = 0; n < 2; ++n) _Pragma("unroll") for (int k = 0; k < 2; ++k) dst[n][k] = *(const PG8_LAS bf16x8*)(lds + PG8_SB(b, h) + boff + n * 2048 + k * 1024); } while (0)
#define PG8_MMA(ai, bj, At, Bt) do { __builtin_amdgcn_s_setprio(1); _Pragma("unroll") for (int m = 0; m < 4; ++m) _Pragma("unroll") for (int n = 0; n < 2; ++n) _Pragma("unroll") for (int k = 0; k < 2; ++k) \
        acc[ai][bj][m][n] = __builtin_amdgcn_mfma_f32_16x16x32_bf16(Bt[n][k], At[m][k], acc[ai][bj][m][n], 0, 0, 0); __builtin_amdgcn_s_setprio(0); } while (0)
#define PG8_WAIT_V(n) asm volatile("s_waitcnt vmcnt(" #n ")" ::: "memory")
#define PG8_WAIT_L(n) asm volatile("s_waitcnt lgkmcnt(" #n ")" ::: "memory")
#define PG8_BAR __builtin_amdgcn_s_barrier()
#define PG8_SCHED __builtin_amdgcn_sched_barrier(0)
    Unit cur, nxt; int ui = 0;
    if (!S.next(0, cur)) return;
    f32x4 acc[2][2][4][2];
#pragma unroll
    for (int a = 0; a < 2; ++a)
#pragma unroll
        for (int b = 0; b < 2; ++b)
#pragma unroll
            for (int m = 0; m < 4; ++m)
#pragma unroll
                for (int n = 0; n < 2; ++n) acc[a][b][m][n] = (f32x4){0.f, 0.f, 0.f, 0.f};
    bf16x8 At[4][2], B0[2][2], B1[2][2];
    const char* cA = (const char*)g.A + (Sched::GATHER ? (size_t)0 : (size_t)cur.pm * tstep); const char* cB = (const char*)g.Bt + S.bofs(cur) + (size_t)cur.pn * tstepB;
    if constexpr (Sched::GATHER) { static_assert(!Sched::GATHER || SP2, "GATHER is wired into the SP2 loop only"); PG8_GLOOK(cur, gc0, gc1); }
    S.a_ready(cur);
    if constexpr (SP2) {
        PG8_STAGE(PG8_SB(0, 0), cB, voffB); PG8_STAGE(PG8_SB(0, 1), cB + hstepB, voffB); PG8_STAGE_AC(PG8_SA(0, 0), cA, 0); PG8_STAGE_AC(PG8_SA(0, 1), cA, 1);
        if (wr == 1) PG8_BAR;
        PG8_WAIT_V(2); PG8_BAR;
        PG8_STAGE(PG8_SB(1, 0), cB + kstepB, voffB); PG8_STAGE_AC(PG8_SA(1, 0), cA + kstep, 0); PG8_STAGE(PG8_SB(1, 1), cB + hstepB + kstepB, voffB);
        PG8_WAIT_V(6); PG8_BAR;
    } else {
        PG8_STAGE(PG8_SB(0, 0), cB, voffB); PG8_STAGE(PG8_SA(0, 0), cA, voffA); PG8_STAGE(PG8_SB(0, 1), cB + hstepB, voffB); PG8_STAGE(PG8_SA(0, 1), cA + hstep, voffA);
        if (wr == 1) PG8_BAR;
        PG8_WAIT_V(4); PG8_BAR;
        PG8_STAGE(PG8_SB(1, 0), cB + kstepB, voffB); PG8_STAGE(PG8_SA(1, 0), cA + kstep, voffA); PG8_STAGE(PG8_SB(1, 1), cB + hstepB + kstepB, voffB);
        PG8_WAIT_V(6); PG8_BAR;
    }
    for (;;) {
        const bool has_next = S.next(ui + 1, nxt);
        const char* nA = (has_next && !Sched::GATHER) ? (const char*)g.A + (size_t)nxt.pm * tstep : cA;
        if constexpr (Sched::GATHER) { if (has_next) PG8_GLOOK(nxt, gn0, gn1); else { gn0[0] = gc0[0]; gn0[1] = gc0[1]; gn1[0] = gc1[0]; gn1[1] = gc1[1]; } } const char* nB = has_next ? (const char*)g.Bt + S.bofs(nxt) + (size_t)nxt.pn * tstepB : cB;
        for (int t = 0; t < nt; t += 2) {
            const bool last = (t == nt - 2);
            if constexpr (Epi::HAS_MID) { if (t == (nt >> 1)) E.mid(acc, cur, wr, wc, fr, fq); }
            const char* a1 = cA + (size_t)(t + 1) * kstep;
            const char* a2 = last ? nA : cA + (size_t)(t + 2) * kstep; const char* b2 = last ? nB : cB + (size_t)(t + 2) * kstepB;
            const char* a3 = a2 + kstep; const char* b3 = b2 + kstepB;
            unsigned gs0[2], gs1[2]; if constexpr (Sched::GATHER) { gs0[0] = last ? gn0[0] : gc0[0]; gs0[1] = last ? gn0[1] : gc0[1]; gs1[0] = last ? gn1[0] : gc1[0]; gs1[1] = last ? gn1[1] : gc1[1]; } else { gs0[0] = gs0[1] = gs1[0] = gs1[1] = 0u; }
            if (last && has_next) S.a_ready(nxt);
            if constexpr (SP2) {
            PG8_LDB(B0, 0, 0); PG8_LDB(B1, 0, 1); PG8_SCHED; PG8_LDA(At, 0, 0); PG8_STAGE_AC(PG8_SA(1, 1), a1, 1);
            PG8_WAIT_V(8); PG8_WAIT_L(0); PG8_BAR; PG8_MMA(0, 0, At, B0); PG8_MMA(0, 1, At, B1); PG8_BAR; PG8_SCHED;
            PG8_LDA(At, 0, 1); PG8_STAGE(PG8_SB(0, 0), b2, voffB); PG8_STAGE(PG8_SB(0, 1), b2 + hstepB, voffB); PG8_STAGE_AS(PG8_SA(0, 0), a2, 0);
            PG8_WAIT_V(8); PG8_WAIT_L(0); PG8_BAR; PG8_MMA(1, 0, At, B0); PG8_MMA(1, 1, At, B1); PG8_BAR; PG8_SCHED;
            PG8_LDB(B0, 1, 0); PG8_LDB(B1, 1, 1); PG8_SCHED; PG8_LDA(At, 1, 0); PG8_STAGE_AS(PG8_SA(0, 1), a2, 1);
            PG8_WAIT_V(8); PG8_WAIT_L(0); PG8_BAR; PG8_MMA(0, 0, At, B0); PG8_MMA(0, 1, At, B1); PG8_BAR; PG8_SCHED;
            PG8_LDA(At, 1, 1); PG8_STAGE(PG8_SB(1, 0), b3, voffB); PG8_STAGE(PG8_SB(1, 1), b3 + hstepB, voffB); PG8_STAGE_AS(PG8_SA(1, 0), a3, 0);
            PG8_WAIT_V(8); PG8_WAIT_L(0); PG8_BAR; PG8_MMA(1, 0, At, B0); PG8_MMA(1, 1, At, B1); PG8_BAR; PG8_SCHED;
            } else {
            PG8_LDB(B0, 0, 0); PG8_SCHED; PG8_LDA(At, 0, 0); PG8_STAGE(PG8_SA(1, 1), a1 + hstep, voffA);
            PG8_WAIT_L(8); PG8_BAR; PG8_WAIT_L(0); PG8_MMA(0, 0, At, B0); PG8_BAR; PG8_SCHED;
            PG8_LDB(B1, 0, 1); PG8_STAGE(PG8_SB(0, 0), b2, voffB);
            PG8_BAR; PG8_WAIT_L(0); PG8_MMA(0, 1, At, B1); PG8_BAR;
            PG8_LDA(At, 0, 1); PG8_STAGE(PG8_SA(0, 0), a2, voffA);
            PG8_BAR; PG8_WAIT_L(0); PG8_MMA(1, 0, At, B0); PG8_BAR; PG8_SCHED;
            PG8_STAGE(PG8_SB(0, 1), b2 + hstepB, voffB);
            PG8_WAIT_V(6); PG8_BAR; PG8_MMA(1, 1, At, B1); PG8_BAR;
            PG8_LDB(B0, 1, 0); PG8_SCHED; PG8_LDA(At, 1, 0); PG8_STAGE(PG8_SA(0, 1), a2 + hstep, voffA);
            PG8_WAIT_L(8); PG8_BAR; PG8_WAIT_L(0); PG8_MMA(0, 0, At, B0); PG8_BAR; PG8_SCHED;
            PG8_LDB(B1, 1, 1); PG8_STAGE(PG8_SB(1, 0), b3, voffB);
            PG8_BAR; PG8_WAIT_L(0); PG8_MMA(0, 1, At, B1); PG8_BAR;
            PG8_LDA(At, 1, 1); PG8_STAGE(PG8_SA(1, 0), a3, voffA);
            PG8_BAR; PG8_WAIT_L(0); PG8_MMA(1, 0, At, B0); PG8_BAR; PG8_SCHED;
            PG8_STAGE(PG8_SB(1, 1), b3 + hstepB, voffB);
            PG8_WAIT_V(6); PG8_BAR; PG8_MMA(1, 1, At, B1); PG8_BAR;
            }
        }
        if constexpr (ALIGN_EPI) { if (wr == 0) PG8_BAR; }
        if constexpr (!Epi::AFTER_DRAIN) { E(acc, cur, wr, wc, fr, fq); S.done(cur); }
        if (!has_next) break;
#pragma unroll
        for (int a = 0; a < 2; ++a)
#pragma unroll
            for (int b = 0; b < 2; ++b)
#pragma unroll
                for (int m = 0; m < 4; ++m)
#pragma unroll
                    for (int n = 0; n < 2; ++n) acc[a][b][m][n] = (f32x4){0.f, 0.f, 0.f, 0.f};
        cur = nxt; cA = nA; cB = nB; ++ui;
        if constexpr (Sched::GATHER) { gc0[0] = gn0[0]; gc0[1] = gn0[1]; gc1[0] = gn1[0]; gc1[1] = gn1[1]; }
        if constexpr (ALIGN_EPI) { if (wr == 1) PG8_BAR; }
    }
    PG8_WAIT_V(0);
    if constexpr (!ALIGN_EPI) { if (wr == 0) PG8_BAR; }
    PG8_BAR;
    if constexpr (Epi::AFTER_DRAIN) { E.fused(acc, cur, wr, wc, fr, fq, lds, wid, lane); S.done(cur); }
#undef PG8_SA
#undef PG8_SB
#undef PG8_STAGE
#undef PG8_STAGE_AC
#undef PG8_STAGE_AS
#undef PG8_GLOOK
#undef PG8_LDA
#undef PG8_LDB
#undef PG8_MMA
#undef PG8_WAIT_V
#undef PG8_WAIT_L
#undef PG8_BAR
#undef PG8_SCHED
}
}

namespace att {
using bf16x8 = __attribute__((ext_vector_type(8))) short;
using s16x4  = __attribute__((ext_vector_type(4))) short;
using f32x16 = __attribute__((ext_vector_type(16))) float;
using u32x4  = __attribute__((ext_vector_type(4))) unsigned;
typedef unsigned short bf16_t;
constexpr int LDR = 1024;
constexpr int SHM_V = 64 * 128 * 2, SHM_K = 64 * 128 * 2;
constexpr int SLOT = SHM_V + SHM_K, NSLOT = 4;
constexpr int LDS_WS = 131072 + 1024;
constexpr int LDS_BIAS = LDS_WS + 8 * 64 * 4;
constexpr int LDS_ATT_BYTES = LDS_BIAS + 2048;
#define KSWZ(row, colB) ((row) * 256 + ((colB) ^ (((row) & 15) << 4)))
#define SBAR() __builtin_amdgcn_sched_barrier(0)
__device__ __forceinline__ int crow(int r, int hi) { return (r & 3) + 8 * (r >> 2) + 4 * hi; }
typedef float f32x2_cv __attribute__((ext_vector_type(2))); typedef __bf16 bf16x2_cv __attribute__((ext_vector_type(2)));
__device__ __forceinline__ unsigned cvtpk(float lo, float hi) { const f32x2_cv v = {lo, hi}; const bf16x2_cv b = __builtin_convertvector(v, bf16x2_cv); return __builtin_bit_cast(unsigned, b); }
__device__ __forceinline__ int v_st(int k, int c) { const int kk = (k & ~0xC) | ((k & 4) << 1) | ((k & 8) >> 1); return ((kk >> 3) * 4 + (c >> 5)) * 512 + ((kk & 7) * 32 + (c & 31)) * 2; }
__device__ __forceinline__ int v_rd_base(int lane) { return ((lane & 3) << 3) | (((lane >> 2) & 3) << 6) | (((lane >> 4) & 1) << 5) | (((lane >> 5) & 1) << 8); }
constexpr int v_rd_off(int d0, int ks, int half) { return d0 * 512 + ks * 4096 + half * 2048; }
template <int OFF> __device__ __forceinline__ s16x4 tr_read(int vb) { s16x4 r; asm volatile("ds_read_b64_tr_b16 %0, %1 offset:%2" : "=&v"(r) : "v"(vb), "i"(OFF) : "memory"); return r; }
template <int D0> __device__ __forceinline__ void pv_one(f32x16& od, int vb, bf16x8 pa0, bf16x8 pa1, bf16x8 pa2, bf16x8 pa3) {
    const s16x4 l0 = tr_read<v_rd_off(D0, 0, 0)>(vb), h0 = tr_read<v_rd_off(D0, 0, 1)>(vb), l1 = tr_read<v_rd_off(D0, 1, 0)>(vb), h1 = tr_read<v_rd_off(D0, 1, 1)>(vb);
    const s16x4 l2 = tr_read<v_rd_off(D0, 2, 0)>(vb), h2 = tr_read<v_rd_off(D0, 2, 1)>(vb), l3 = tr_read<v_rd_off(D0, 3, 0)>(vb), h3 = tr_read<v_rd_off(D0, 3, 1)>(vb);
    asm volatile("s_waitcnt lgkmcnt(0)" ::: "memory"); SBAR();
#define PK(L, H) (bf16x8){L[0], L[1], L[2], L[3], H[0], H[1], H[2], H[3]}
    od = __builtin_amdgcn_mfma_f32_32x32x16_bf16(pa0, PK(l0, h0), od, 0, 0, 0);
    od = __builtin_amdgcn_mfma_f32_32x32x16_bf16(pa1, PK(l1, h1), od, 0, 0, 0);
    od = __builtin_amdgcn_mfma_f32_32x32x16_bf16(pa2, PK(l2, h2), od, 0, 0, 0);
    od = __builtin_amdgcn_mfma_f32_32x32x16_bf16(pa3, PK(l3, h3), od, 0, 0, 0);
#undef PK
}
__device__ __forceinline__ void pv_d0(f32x16* o, int vb, bf16x8 pa0, bf16x8 pa1, bf16x8 pa2, bf16x8 pa3) {
    pv_one<0>(o[0], vb, pa0, pa1, pa2, pa3); pv_one<1>(o[1], vb, pa0, pa1, pa2, pa3); pv_one<2>(o[2], vb, pa0, pa1, pa2, pa3); pv_one<3>(o[3], vb, pa0, pa1, pa2, pa3);
}
template <int D0, int KB> __device__ __forceinline__ void pvb_one(f32x16& od, int vb, bf16x8 pa, bf16x8 pb) {
    const s16x4 l0 = tr_read<v_rd_off(D0, 2 * KB, 0)>(vb), h0 = tr_read<v_rd_off(D0, 2 * KB, 1)>(vb), l1 = tr_read<v_rd_off(D0, 2 * KB + 1, 0)>(vb), h1 = tr_read<v_rd_off(D0, 2 * KB + 1, 1)>(vb);
    asm volatile("s_waitcnt lgkmcnt(0)" ::: "memory"); SBAR();
#define PK(L, H) (bf16x8){L[0], L[1], L[2], L[3], H[0], H[1], H[2], H[3]}
    od = __builtin_amdgcn_mfma_f32_32x32x16_bf16(pa, PK(l0, h0), od, 0, 0, 0);
    od = __builtin_amdgcn_mfma_f32_32x32x16_bf16(pb, PK(l1, h1), od, 0, 0, 0);
#undef PK
}
template <int D0, int ND> __device__ __forceinline__ void qkt(f32x16& p0, f32x16& p1, const char* Ks, const bf16x8* qr, int r32, int hi) {
    p0 = f32x16{}; p1 = f32x16{};
#pragma unroll
    for (int d0 = D0; d0 < D0 + ND; ++d0) { const int cb = (d0 * 16 + hi * 8) * 2;
        const bf16x8 b0 = *reinterpret_cast<const bf16x8*>(Ks + KSWZ(r32, cb));
        const bf16x8 b1 = *reinterpret_cast<const bf16x8*>(Ks + KSWZ(32 + r32, cb));
        p0 = __builtin_amdgcn_mfma_f32_32x32x16_bf16(b0, qr[d0], p0, 0, 0, 0);
        p1 = __builtin_amdgcn_mfma_f32_32x32x16_bf16(b1, qr[d0], p1, 0, 0, 0); }
}
__device__ __forceinline__ void pack_p(const f32x16& p0, const f32x16& p1, bf16x8& pa0, bf16x8& pa1, bf16x8& pa2, bf16x8& pa3) {
#define PK4(P, BASE, OUT) do { unsigned a0 = cvtpk(P[BASE + 0], P[BASE + 1]), a1 = cvtpk(P[BASE + 2], P[BASE + 3]);   \
    unsigned b0 = cvtpk(P[BASE + 4], P[BASE + 5]), b1 = cvtpk(P[BASE + 6], P[BASE + 7]);                              \
    auto r0 = __builtin_amdgcn_permlane32_swap(a0, b0, false, false); auto r1 = __builtin_amdgcn_permlane32_swap(a1, b1, false, false); \
    u32x4 w = {r0[0], r1[0], r0[1], r1[1]}; OUT = *reinterpret_cast<bf16x8*>(&w); } while (0)
    PK4(p0, 0, pa0); PK4(p0, 8, pa1); PK4(p1, 0, pa2); PK4(p1, 8, pa3);
#undef PK4
}
__device__ __forceinline__ float half_sum(float v) { auto rr = __builtin_amdgcn_permlane32_swap(__float_as_uint(v), __float_as_uint(v), false, false); return __uint_as_float(rr[0]) + __uint_as_float(rr[1]); }

struct Stager {
    int sr, sc, vst0, vst1; bf16x8 vs0, vs1, ks0, ks1;
    __device__ __forceinline__ void init(int tid) { sr = tid >> 4; sc = (tid & 15) * 8; vst0 = v_st(sr, sc); vst1 = v_st(32 + sr, sc); }
    __device__ __forceinline__ void load(const bf16_t* Kt, const bf16_t* Vt) {
        vs0 = *reinterpret_cast<const bf16x8*>(Vt + (size_t)sr * LDR + sc); vs1 = *reinterpret_cast<const bf16x8*>(Vt + (size_t)(32 + sr) * LDR + sc);
        ks0 = *reinterpret_cast<const bf16x8*>(Kt + (size_t)sr * LDR + sc); ks1 = *reinterpret_cast<const bf16x8*>(Kt + (size_t)(32 + sr) * LDR + sc);
    }
    __device__ __forceinline__ void write(char* lds, int b) {
        *(bf16x8*)(lds + b * SHM_V + vst0) = vs0; *(bf16x8*)(lds + b * SHM_V + vst1) = vs1; const int kc = sc * 2;
        *(bf16x8*)(lds + 2 * SHM_V + b * SHM_K + KSWZ(sr, kc)) = ks0; *(bf16x8*)(lds + 2 * SHM_V + b * SHM_K + KSWZ(32 + sr, kc)) = ks1;
    }
};

typedef float f32x4v __attribute__((ext_vector_type(4)));
#define MFMA16(a, b, c) __builtin_amdgcn_mfma_f32_16x16x32_bf16(a, b, c, 0, 0, 0)
template <int DT, int KB> __device__ __forceinline__ void pvb16_pair(f32x4v (&o)[2][8], int vb, bf16x8 pa, bf16x8 pb) {
    const s16x4 l0 = tr_read<((2 * KB) * 8 + DT) * 512>(vb), h0 = tr_read<((2 * KB + 1) * 8 + DT) * 512>(vb), l1 = tr_read<((2 * KB) * 8 + DT + 1) * 512>(vb), h1 = tr_read<((2 * KB + 1) * 8 + DT + 1) * 512>(vb);
    asm volatile("s_waitcnt lgkmcnt(0)" ::: "memory"); SBAR();
#define PK(L, H) (bf16x8){L[0], L[1], L[2], L[3], H[0], H[1], H[2], H[3]}
    o[0][DT] = MFMA16(pa, PK(l0, h0), o[0][DT]); o[1][DT] = MFMA16(pb, PK(l0, h0), o[1][DT]);
    o[0][DT + 1] = MFMA16(pa, PK(l1, h1), o[0][DT + 1]); o[1][DT + 1] = MFMA16(pb, PK(l1, h1), o[1][DT + 1]);
#undef PK
}
__device__ __forceinline__ void diff_epilogue(f32x4v (&o)[2][8], float l0, float l1, int b, int h, int qb, bf16_t* Y, float lam, const float* subln, char* lds);
__device__ __forceinline__ void diff_unit(int b, int h, int qb, const bf16_t* QA, const bf16_t* KA, const bf16_t* VA, bf16_t* Y, float lam, const float* subln, char* lds, __attribute__((address_space(3))) unsigned char* lds3) {
    int tid = threadIdx.x; asm volatile("" : "+v"(tid));
    const int lane = tid & 63, l15 = lane & 15, g = lane >> 4; const int wid = __builtin_amdgcn_readfirstlane(tid >> 6); const int br = wid >> 2, wq = wid & 3;
    const size_t qrow0 = (size_t)b * SEQ + (size_t)qb * 128 + wq * 32;
    const bf16_t* Kc = KA + ((size_t)MTOK + (size_t)b * CTXL) * LDR + h * 128; const bf16_t* Kl = KA + ((size_t)b * SEQ) * LDR + h * 128;
    const bf16_t* Vc = VA + ((size_t)MTOK + (size_t)b * CTXL) * LDR + h * 128; const bf16_t* Vl = VA + ((size_t)b * SEQ) * LDR + h * 128;
    constexpr int NT = (CTXL + SEQ) / 64;
    bf16x8 qr[2][2];
#pragma unroll
    for (int qt = 0; qt < 2; ++qt)
#pragma unroll
        for (int ds = 0; ds < 2; ++ds) qr[qt][ds] = *reinterpret_cast<const bf16x8*>(QA + (qrow0 + 16 * qt + l15) * LDR + h * 128 + br * 64 + 32 * ds + 8 * g);
    unsigned koff[2], voff[2];
#pragma unroll
    for (int i = 0; i < 2; ++i) { const int p = 2 * wid + i;
        const int krow = 4 * p + (lane >> 4), kch = (lane & 15) ^ (krow & 15); koff[i] = (unsigned)(krow * LDR + 8 * kch) * 2u;
        const int sub = 2 * p + (lane >> 5), key = (sub >> 3) * 16 + ((lane & 31) >> 1), col = (sub & 7) * 16 + 8 * (lane & 1);
        voff[i] = (unsigned)(key * LDR + col) * 2u; }
    const int vb0 = (int)(uintptr_t)lds + (4 * g + (l15 >> 2)) * 32 + (l15 & 3) * 8;
    const int kcb = br * 128 + g * 16;
    const unsigned pw = (unsigned)wid * 2048u;
#define TILE_K(t) ((const char*)((t) < 4 ? Kc + (size_t)(t) * 64 * LDR : Kl + (size_t)((t) - 4) * 64 * LDR))
#define TILE_V(t) ((const char*)((t) < 4 ? Vc + (size_t)(t) * 64 * LDR : Vl + (size_t)((t) - 4) * 64 * LDR))
#define DMA(t, so) do { const char* kt_ = TILE_K(t); const char* vt_ = TILE_V(t); \
    _Pragma("unroll") for (int i_ = 0; i_ < 2; ++i_) { \
        __builtin_amdgcn_global_load_lds((const unsigned*)(vt_ + voff[i_]), (__attribute__((address_space(3))) unsigned*)(lds3 + (so) + pw + i_ * 1024), 16, 0, 0); \
        __builtin_amdgcn_global_load_lds((const unsigned*)(kt_ + koff[i_]), (__attribute__((address_space(3))) unsigned*)(lds3 + (so) + SHM_V + pw + i_ * 1024), 16, 0, 0); } } while (0)
#define WAITBAR(n) asm volatile("s_waitcnt vmcnt(" #n ") lgkmcnt(0)\n\ts_barrier" ::: "memory")
#define QKB(P, so, kb) do { const char* Ks_ = lds + (so) + SHM_V; P[0] = f32x4v{}; P[1] = f32x4v{}; P[2] = f32x4v{}; P[3] = f32x4v{}; \
    _Pragma("unroll") for (int ds_ = 0; ds_ < 2; ++ds_) \
    _Pragma("unroll") for (int kt_ = 0; kt_ < 2; ++kt_) { \
        const bf16x8 a_ = *reinterpret_cast<const bf16x8*>(Ks_ + (32 * (kb) + 16 * kt_ + l15) * 256 + ((kcb + 64 * ds_) ^ (l15 << 4))); \
        P[kt_ * 2] = MFMA16(a_, qr[0][ds_], P[kt_ * 2]); P[kt_ * 2 + 1] = MFMA16(a_, qr[1][ds_], P[kt_ * 2 + 1]); } } while (0)
#define PKT(P, T0, T1, OUT) do { u32x4 w_ = {cvtpk(P[T0][0], P[T0][1]), cvtpk(P[T0][2], P[T0][3]), cvtpk(P[T1][0], P[T1][1]), cvtpk(P[T1][2], P[T1][3])}; OUT = *reinterpret_cast<bf16x8*>(&w_); } while (0)
#define FINB(P) do { float p0_ = 0.f, p1_ = 0.f; _Pragma("unroll") for (int e_ = 0; e_ < 4; ++e_) { \
        P[0][e_] = __builtin_amdgcn_exp2f(P[0][e_]); P[1][e_] = __builtin_amdgcn_exp2f(P[1][e_]); P[2][e_] = __builtin_amdgcn_exp2f(P[2][e_]); P[3][e_] = __builtin_amdgcn_exp2f(P[3][e_]); \
        p0_ += P[0][e_] + P[2][e_]; p1_ += P[1][e_] + P[3][e_]; } \
    l0 += p0_; l1 += p1_; PKT(P, 0, 2, paA); PKT(P, 1, 3, paB); } while (0)
#define PVB(so, kb) do { const int vb_ = vb0 + (so); pvb16_pair<0, kb>(o, vb_, paA, paB); pvb16_pair<2, kb>(o, vb_, paA, paB); pvb16_pair<4, kb>(o, vb_, paA, paB); pvb16_pair<6, kb>(o, vb_, paA, paB); } while (0)
#define ROT() do { s_prev = s_cur; s_cur = s_nxt; s_nxt = s_nx2; s_nx2 = (s_nx2 == (NSLOT - 1) * SLOT) ? 0 : s_nx2 + SLOT; } while (0)
    f32x4v o[2][8];
#pragma unroll
    for (int qt = 0; qt < 2; ++qt)
#pragma unroll
        for (int d = 0; d < 8; ++d) o[qt][d] = f32x4v{};
    float l0 = 0.f, l1 = 0.f; f32x4v pX[4], pY[4]; bf16x8 paA, paB;
    int s_prev = 0, s_cur = 0, s_nxt = SLOT, s_nx2 = 2 * SLOT;
    DMA(0, 0); DMA(1, SLOT);
    WAITBAR(4);
    DMA(2, 2 * SLOT);
    QKB(pX, 0, 0);
    SBAR(); QKB(pY, 0, 1); FINB(pX); SBAR();
    PVB(0, 0);
    WAITBAR(4);
    ROT();
#define STEP(j, HAS2) do { \
    if (HAS2) DMA((j) + 2, s_nx2); \
    SBAR(); QKB(pX, s_cur, 0); FINB(pY); SBAR(); \
    PVB(s_prev, 1); \
    SBAR(); QKB(pY, s_cur, 1); FINB(pX); SBAR(); \
    PVB(s_cur, 0); \
    if (HAS2) WAITBAR(4); else WAITBAR(0); \
    ROT(); } while (0)
    for (int j = 1; j + 2 < NT; ++j) STEP(j, true);
    STEP(NT - 2, false);
    STEP(NT - 1, false);
    FINB(pY); SBAR();
    PVB(s_prev, 1);
#undef QKB
#undef PKT
#undef FINB
#undef PVB
#undef TILE_K
#undef TILE_V
#undef DMA
#undef ROT
#undef STEP
#undef WAITBAR
    l0 += __shfl_xor(l0, 16); l0 += __shfl_xor(l0, 32); l1 += __shfl_xor(l1, 16); l1 += __shfl_xor(l1, 32);
    diff_epilogue(o, l0, l1, b, h, qb, Y, lam, subln, lds);
}
__device__ __forceinline__ void diff_epilogue(f32x4v (&o)[2][8], float l0, float l1, int b, int h, int qb, bf16_t* Y, float lam, const float* subln, char* lds) {
    int tid = threadIdx.x; asm volatile("" : "+v"(tid));
    const int lane = tid & 63, l15 = lane & 15, g = lane >> 4; const int wid = __builtin_amdgcn_readfirstlane(tid >> 6); const int br = wid >> 2, wq = wid & 3;
    float* ws = (float*)(lds + LDS_WS) + wid * 64;
    const size_t qrow0 = (size_t)b * SEQ + (size_t)qb * 128 + wq * 32;
#define WAITBAR(n) asm volatile("s_waitcnt vmcnt(" #n ") lgkmcnt(0)\n\ts_barrier" ::: "memory")
    if (g == 0) { ws[l15] = l0; ws[16 + l15] = l1; }
    WAITBAR(0);
    float* xb = (float*)lds + wq * 4096 + lane;
    if (br == 1) {
#pragma unroll
        for (int qt = 0; qt < 2; ++qt)
#pragma unroll
            for (int i = 0; i < 4; ++i) { const float i2 = lam * __builtin_amdgcn_rcpf(ws[16 * qt + 4 * g + i]);
#pragma unroll
                for (int d = 0; d < 8; ++d) xb[((qt * 8 + d) * 4 + i) * 64] = o[qt][d][i] * i2; }
    }
    WAITBAR(0);
    if (br == 0) {
        float sg[8];
#pragma unroll
        for (int d = 0; d < 8; ++d) sg[d] = subln[d * 16 + l15] * 0.8f;
#pragma unroll
        for (int qt = 0; qt < 2; ++qt)
#pragma unroll
            for (int i = 0; i < 4; ++i) { const int orow = 16 * qt + 4 * g + i; const float i1 = __builtin_amdgcn_rcpf(ws[orow]);
                float y[8], ss = 0.f;
#pragma unroll
                for (int d = 0; d < 8; ++d) { y[d] = o[qt][d][i] * i1 - xb[((qt * 8 + d) * 4 + i) * 64]; ss += y[d] * y[d]; }
                ss += __shfl_xor(ss, 1); ss += __shfl_xor(ss, 2); ss += __shfl_xor(ss, 4); ss += __shfl_xor(ss, 8);
                const float rs = __builtin_amdgcn_rsqf(ss * (1.0f / 128.0f) + EPS);
                bf16_t* yp = Y + (qrow0 + orow) * DM + h * 128 + l15;
#pragma unroll
                for (int d = 0; d < 8; ++d) { const unsigned w = cvtpk(y[d] * rs * sg[d], 0.f); yp[d * 16] = (bf16_t)(w & 0xffffu); } }
    }
    WAITBAR(0);
#undef WAITBAR
}

__device__ __forceinline__ void na_unit(int b, int h, int rb, const bf16_t* QB, const bf16_t* KB, const bf16_t* VB, bf16_t* Y, const float* rpb, char* lds) {
    const int tid = threadIdx.x, lane = tid & 63, r32 = lane & 31, hi = lane >> 5; const int wid = __builtin_amdgcn_readfirstlane(tid >> 6);
    float* ws = (float*)(lds + LDS_WS) + wid * 64; float* bias = (float*)(lds + LDS_BIAS);
    if (tid < 15 * 31) bias[(tid / 31) * 128 + 48 + tid % 31] = rpb[h * 465 + tid] * LOG2E;
    const int R0 = rb * 4, rq = R0 + (wid >> 1), half = wid & 1, qc = half * 32 + r32;
    const int cs = min(max(qc - 8, 0), GRIDW - 16);
    const int rs0 = min(max(rq - 4, 0), GROWS - 8);
    const int krlo = min(max(R0 - 4, 0), GROWS - 8), krhi = min(max(R0 + 3 - 4, 0), GROWS - 8) + 7;
    int nlat = krhi - krlo + 1; const int NT = 4 + nlat;
    const size_t qrow0 = (size_t)b * SEQ + (size_t)R0 * 64 + wid * 32;
    bf16x8 qr[8];
    { const bf16_t* Qw = QB + (qrow0 + r32) * LDR + h * 128 + hi * 8;
#pragma unroll
      for (int d0 = 0; d0 < 8; ++d0) qr[d0] = *reinterpret_cast<const bf16x8*>(Qw + d0 * 16); }
    const bf16_t* Kc = KB + ((size_t)MTOK + (size_t)b * CTXL) * LDR + h * 128; const bf16_t* Kl = KB + ((size_t)b * SEQ + (size_t)krlo * 64) * LDR + h * 128;
    const bf16_t* Vc = VB + ((size_t)MTOK + (size_t)b * CTXL) * LDR + h * 128; const bf16_t* Vl = VB + ((size_t)b * SEQ + (size_t)krlo * 64) * LDR + h * 128;
    Stager st; st.init(tid);
    const int vb0 = (int)(uintptr_t)lds + v_rd_base(lane);
    f32x16 o[4];
#pragma unroll
    for (int d = 0; d < 4; ++d) o[d] = f32x16{};
    float l = 0.f;
    st.load(Kc, Vc); asm volatile("s_waitcnt vmcnt(0)" ::: "memory"); st.write(lds, 0); __syncthreads();
    for (int j = 0; j < NT; ++j) {
        const int cur = j & 1;
        if (j + 1 < NT) { const int t = j + 1; if (t < 4) st.load(Kc + (size_t)t * 64 * LDR, Vc + (size_t)t * 64 * LDR); else st.load(Kl + (size_t)(t - 4) * 64 * LDR, Vl + (size_t)(t - 4) * 64 * LDR); }
        const int kr = krlo + j - 4;
        const bool active = (j < 4) || (kr >= rs0 && kr <= rs0 + 7);
        if (active) {
            const char* Ks = lds + 2 * SHM_V + cur * SHM_K; const int vb = vb0 + cur * SHM_V;
            f32x16 p0, p1; bf16x8 pa0, pa1, pa2, pa3;
            qkt<0, 8>(p0, p1, Ks, qr, r32, hi);
            if (j >= 4) {
                const float* brow = bias + (kr - rq + 7) * 128 + 48 + (15 - qc + 4 * hi); const int dc = 4 * hi - cs;
#pragma unroll
                for (int r = 0; r < 16; ++r) { const int c0 = (r & 3) + 8 * (r >> 2);
                    const float s0 = p0[r] + brow[c0], s1 = p1[r] + brow[c0 + 32];
                    p0[r] = ((unsigned)(c0 + dc) < 16u) ? __builtin_amdgcn_exp2f(s0) : 0.f;
                    p1[r] = ((unsigned)(c0 + 32 + dc) < 16u) ? __builtin_amdgcn_exp2f(s1) : 0.f;
                    if ((r & 3) == 3) SBAR(); }
            } else {
#pragma unroll
                for (int r = 0; r < 16; ++r) { p0[r] = __builtin_amdgcn_exp2f(p0[r]); p1[r] = __builtin_amdgcn_exp2f(p1[r]); }
            }
            { float ps = 0.f;
#pragma unroll
              for (int r = 0; r < 16; ++r) ps += p0[r] + p1[r];
              l += ps; }
            pack_p(p0, p1, pa0, pa1, pa2, pa3); SBAR();
            pv_d0(o, vb, pa0, pa1, pa2, pa3);
        }
        if (j + 1 < NT) { asm volatile("s_waitcnt vmcnt(0)" ::: "memory"); st.write(lds, cur ^ 1); }
        __syncthreads();
    }
    l = half_sum(l);
    if (hi == 0) ws[r32] = l; asm volatile("s_waitcnt lgkmcnt(0)" ::: "memory");
#pragma unroll
    for (int r = 0; r < 16; ++r) { const int orow = crow(r, hi); const float il = __builtin_amdgcn_rcpf(ws[orow]);
        bf16_t* yp = Y + (qrow0 + orow) * DM + 1024 + h * 128 + r32;
#pragma unroll
        for (int d = 0; d < 4; ++d) { const unsigned w = cvtpk(o[d][r] * il, 0.f); yp[d * 32] = (bf16_t)(w & 0xffffu); } }
    __syncthreads();
}
#undef KSWZ
#undef SBAR
}

constexpr int NWAVES = 8;
constexpr int N_LAUNCHES = MK_N_LAUNCHES;
constexpr int PER_PHASE = 13;
static_assert(N_LAUNCHES == 1 || N_LAUNCHES == PER_PHASE, "MK_N_LAUNCHES is 1 or 13");

constexpr size_t MiB = 1u << 20;
constexpr size_t WS_CTL = 0, CTL_ZERO_BYTES = 1 * MiB;
constexpr size_t WS_MOD = 1 * MiB;
constexpr size_t WS_GAINS = 1 * MiB + 384 * 1024;
constexpr size_t WS_ROPE = 1 * MiB + 512 * 1024;
constexpr size_t WS_WIN = 2 * MiB, WS_WAB = 42 * MiB, WS_WO = 50 * MiB, WS_WGU = 58 * MiB, WS_WD = 314 * MiB;
constexpr size_t WS_ROWSQ = 442 * MiB;
constexpr size_t WS_AFF = 446 * MiB;
constexpr size_t WS_TOK = 448 * MiB;
constexpr size_t WS_GSEL = WS_TOK + 256 * 1024;
constexpr size_t WS_INV = 449 * MiB;
constexpr size_t WS_H = 452 * MiB;
constexpr size_t WS_PB = 584 * MiB, PB_STRIDE = 66 * MiB;
constexpr size_t WS_GATE = 980 * MiB;
constexpr size_t WS_U = WS_PB;
constexpr size_t WS_XE = WS_PB + 2 * PB_STRIDE;
constexpr size_t WS_END = 1236 * MiB;
static_assert(WS_H + (size_t)MALL * DM * 2 <= WS_PB && WS_PB + 6 * PB_STRIDE <= WS_GATE && WS_GATE + (size_t)MTOK * 4096 * 2 <= WS_END, "d_ws map");
static_assert(WS_U + (size_t)MTOK * UP * 2 <= WS_XE && WS_XE + (size_t)MSLOT * DM * 2 <= WS_GATE && (size_t)MALL * 1024 * 2 <= PB_STRIDE, "d_ws overlays");
static_assert(WS_WD + (size_t)NE * DM * FF * 2 <= WS_ROWSQ && WS_INV + (size_t)MTOK * 16 * 4 <= WS_H, "d_ws map 2");
constexpr int CW_TMO = 0, CW_CODE = 1, CW_BAR = 4096;

constexpr int RING_OFF = 0, RING_BYTES = 131072;
constexpr int LDSCTL_OFF = RING_BYTES, MISC_OFF = LDSCTL_OFF + 320;
constexpr int LDS_BYTES = 147456;
constexpr int EPI_X_OFF = 136192;
static_assert(EPI_X_OFF >= att::LDS_ATT_BYTES && EPI_X_OFF + 8192 <= LDS_BYTES, "LDS map: epilogue exchange table");
static_assert(MISC_OFF + 128 <= att::LDS_WS && att::LDS_ATT_BYTES <= LDS_BYTES && att::NSLOT * att::SLOT <= RING_BYTES, "LDS map");

#define GAS __attribute__((address_space(1)))
#define LAS __attribute__((address_space(3)))
typedef unsigned short bf16;
typedef unsigned v4u __attribute__((ext_vector_type(4)));
typedef unsigned v2u __attribute__((ext_vector_type(2)));
typedef float f32x4 __attribute__((ext_vector_type(4)));
typedef GAS unsigned gu32;
#define RLX_AGENT __ATOMIC_RELAXED, __HIP_MEMORY_SCOPE_AGENT
#define LDS_WAIT() asm volatile("s_waitcnt lgkmcnt(0)" ::: "memory")
#define VM_WAIT() asm volatile("s_waitcnt vmcnt(0)" ::: "memory")
__device__ __forceinline__ unsigned f2bf(float f) { unsigned u = __builtin_bit_cast(unsigned, f); return (u + 0x7fffu + ((u >> 16) & 1u)) >> 16; }
__device__ __forceinline__ unsigned pk2(float lo, float hi) { return f2bf(lo) | (f2bf(hi) << 16); }
__device__ __forceinline__ float bflo(unsigned w) { return __uint_as_float(w << 16); }
__device__ __forceinline__ float bfhi(unsigned w) { return __uint_as_float(w & 0xffff0000u); }

#define XB_TMO      128
#define XB_XCNT(j)  (256  + 64 * (j))
#define XB_XSUB(j)  (1280 + 64 * (j))
#define XB_XGEN(j)  (2304 + 64 * (j))
#define XB_TOP      3328
#define XB_TOPGEN   3392
#define XCD_BAR_WORDS 3456
#define XB_SPIN_CAP (1u << 18)

__device__ __forceinline__ unsigned xb_ld(unsigned* p)              { return __hip_atomic_load(p, __ATOMIC_RELAXED, __HIP_MEMORY_SCOPE_AGENT); }
__device__ __forceinline__ unsigned xb_add(unsigned* p, unsigned v) { return __hip_atomic_fetch_add(p, v, __ATOMIC_RELAXED, __HIP_MEMORY_SCOPE_AGENT); }
__device__ __forceinline__ unsigned xb_xcc_id() { return (unsigned)__builtin_amdgcn_s_getreg((3 << 11) | 20) & 0xFu; }
#define XB_SPIN(cond, bar) do { unsigned _sp = 0; while (cond) { __builtin_amdgcn_s_sleep(1); \
    if ((++_sp & 255u) == 0u) { if (xb_ld(&(bar)[XB_TMO])) break; if (_sp > XB_SPIN_CAP) { atomicAdd(&(bar)[XB_TMO], 1u); break; } } } } while (0)

struct XcdBarrier {
    unsigned* bar; unsigned x;
    volatile LAS unsigned* st;
};

__device__ __forceinline__ XcdBarrier xcd_barrier_post(unsigned* bar, volatile LAS unsigned* st) {
    XcdBarrier b; b.bar = bar; b.x = xb_xcc_id(); b.st = st;
    if (threadIdx.x == 0) (void)xb_add(&bar[XB_XCNT(b.x)], 1u);
    return b;
}
__device__ __forceinline__ void xcd_barrier_complete(unsigned* bar, unsigned x, unsigned& nloc, unsigned& nx) {
    const unsigned G = gridDim.x * gridDim.y * gridDim.z;
    unsigned sum, cnt, mine, sp = 0u;
    for (;;) {
        sum = 0u; cnt = 0u; mine = 0u;
#pragma unroll
        for (unsigned j = 0; j < 16; ++j) { const unsigned c = xb_ld(&bar[XB_XCNT(j)]); sum += c; cnt += (c > 0u) ? 1u : 0u; mine = (j == x) ? c : mine; }
        if (sum == G) break;
        __builtin_amdgcn_s_sleep(1);
        if ((++sp & 255u) == 0u) { if (xb_ld(&bar[XB_TMO])) break; if (sp > XB_SPIN_CAP) { atomicAdd(&bar[XB_TMO], 1u); break; } }
    }
    nloc = mine > 0u ? mine : 1u; nx = cnt > 0u ? cnt : 1u;
}

__device__ __forceinline__ void xcd_barrier(const XcdBarrier& b) {
    asm volatile("s_waitcnt vmcnt(0)" ::: "memory");
    __syncthreads();
    if (threadIdx.x == 0) {
        unsigned* bar = b.bar;
        __builtin_amdgcn_s_waitcnt(0);
        unsigned nloc = b.st[0], nx = b.st[1];
        if (nloc == 0u) { xcd_barrier_complete(bar, b.x, nloc, nx); b.st[0] = nloc; b.st[1] = nx; }
        const unsigned old = xb_add(&bar[XB_XSUB(b.x)], 1u);
        const unsigned gen = old / nloc;
        if (old + 1u == (gen + 1u) * nloc) {
            __builtin_amdgcn_fence(__ATOMIC_RELEASE, "agent");
            asm volatile("s_waitcnt vmcnt(0)" ::: "memory");
            const unsigned og = xb_add(&bar[XB_TOP], 1u);
            const unsigned tg = og / nx;
            if (og + 1u == (tg + 1u) * nx) xb_add(&bar[XB_TOPGEN], 1u);
            else XB_SPIN(xb_ld(&bar[XB_TOPGEN]) == tg, bar);
            __builtin_amdgcn_fence(__ATOMIC_ACQUIRE, "agent");
            xb_add(&bar[XB_XGEN(b.x)], 1u);
            asm volatile("s_waitcnt vmcnt(0)" ::: "memory");
        } else {
            XB_SPIN(xb_ld(&bar[XB_XGEN(b.x)]) == gen, bar);
            __builtin_amdgcn_fence(__ATOMIC_ACQUIRE, "agent");
            asm volatile("s_waitcnt vmcnt(0)" ::: "memory");
        }
    }
    __syncthreads();
}

struct Frame {
    LAS unsigned char* lds;
    volatile LAS unsigned* MISC;
    gu32* ctl;
    int wave;
    int vcu, G;
};
struct Args {
    const float* in[26]; float* out; unsigned char* ws; int ph_lo, ph_hi, li, pad;
};
enum InIdx { I_X = 0, I_C, I_CTX, I_CCTX, I_WMOD, I_BMOD, I_G1, I_G2, I_WIN, I_QGA, I_KGA, I_LQ1, I_LK1, I_LQ2, I_LK2, I_SUBLN, I_QGB, I_KGB, I_RPB, I_WA, I_WB, I_WOUT, I_WR, I_WEG, I_WEU, I_WED };

__device__ __forceinline__ int ph_tid() { int t = threadIdx.x; asm volatile("" : "+v"(t)); return t; }
__device__ __forceinline__ float wave_sum(float v) {
#pragma unroll
    for (int o = 1; o < 64; o <<= 1) v += __shfl_xor(v, o);
    return v;
}
__device__ __forceinline__ float silu_f(float v) { return v / (1.0f + __expf(-v)); }

__device__ __forceinline__ void p0_mod(Frame& F, const Args& a, float* mod) {
    const int tid = ph_tid(), lane = tid & 63; (void)lane;
    LAS float* sv = (LAS float*)(F.lds + RING_OFF);
    LAS float* red = (LAS float*)(F.lds + RING_OFF + 40960);
    const float* c = a.in[I_C]; const float* cctx = a.in[I_CCTX]; const float* wmod = a.in[I_WMOD]; const float* bmod = a.in[I_BMOD];
    for (int i = tid; i < 5 * DM; i += NWAVES * 64) { const int r = i / DM, k = i % DM; sv[i] = silu_f(r < 4 ? c[r * DM + k] : cctx[k]); }
    __syncthreads();
    for (int s = blockIdx.x; s < 256; s += F.G) {
        const int cg = tid % 12, kl = tid / 12;
        float acc[5][4];
#pragma unroll
        for (int r = 0; r < 5; ++r)
#pragma unroll
            for (int e = 0; e < 4; ++e) acc[r][e] = 0.f;
        if (kl < 42) {
            for (int k = kl; k < DM; k += 42) { const f32x4 w = *(const f32x4*)(wmod + (size_t)k * 12288 + 48 * s + 4 * cg);
#pragma unroll
                for (int r = 0; r < 5; ++r) { const float sk = sv[r * DM + k];
#pragma unroll
                    for (int e = 0; e < 4; ++e) acc[r][e] += sk * w[e]; } }
#pragma unroll
            for (int r = 0; r < 5; ++r)
#pragma unroll
                for (int e = 0; e < 4; ++e) red[(kl * 12 + cg) * 20 + r * 4 + e] = acc[r][e];
        }
        __syncthreads();
        if (tid < 240) { const int r = tid / 48, col = tid % 48, g = col >> 2, e = col & 3; float t = 0.f;
            for (int q = 0; q < 42; ++q) t += red[(q * 12 + g) * 20 + r * 4 + e];
            mod[(size_t)r * 12288 + 48 * s + col] = t + bmod[48 * s + col]; }
        __syncthreads();
    }
}
__device__ __forceinline__ size_t b_tile_off(int drow, int k, int ntk, bool perm) {
    const int pn = drow >> 8, nl = drow & 255, h = nl >> 7, r = nl & 127, w = r & 31;
    const int rho = perm ? (r & ~31) + (16 * ((w >> 2) & 1) + 4 * (w >> 3) + (w & 3)) : r;
    return ((((size_t)pn * ntk + (k >> 6)) * 2 + h) * 16384 + (size_t)pg8::lds_byte(rho, k & 63)) >> 1;
}
__device__ __forceinline__ void p0_transpose_item(const float* W, int ldw, int k0, int n0, bf16* WT, int ldt, int drow0, int kdst0, LAS float* scr, int lane, bool perm) {
#pragma unroll 8
    for (int i = 0; i < 32; ++i) { const int kk = 2 * i + (lane >> 5); scr[kk * 33 + (lane & 31)] = W[(size_t)(k0 + kk) * ldw + n0 + (lane & 31)]; }
    LDS_WAIT(); asm volatile("" ::: "memory");
    const int c = lane & 7;
#pragma unroll
    for (int j = 0; j < 4; ++j) { const int n = (lane >> 3) + 8 * j; const LAS float* s = scr + (8 * c) * 33 + n;
        v4u o; o.x = pk2(s[0 * 33], s[1 * 33]); o.y = pk2(s[2 * 33], s[3 * 33]); o.z = pk2(s[4 * 33], s[5 * 33]); o.w = pk2(s[6 * 33], s[7 * 33]);
        *(GAS v4u*)(WT + b_tile_off(drow0 + n, kdst0 + k0 + 8 * c, ldt >> 6, perm)) = o; }
    LDS_WAIT(); asm volatile("" ::: "memory");
}
__device__ __forceinline__ void p0_expert_item(const Args& a, int r, LAS float* scr, int lane) {
    constexpr int I_E = 32 * 64;
    bf16* Wgu = (bf16*)(a.ws + WS_WGU); bf16* Wd = (bf16*)(a.ws + WS_WD);
    const int which = r / (NE * I_E); r -= which * (NE * I_E);
    const int e = r / I_E; r -= e * I_E; const int kb = r / 64, nb = r % 64, n0 = 32 * nb;
    if (which == 0)      p0_transpose_item(a.in[I_WEG] + (size_t)e * DM * FF, FF, 64 * kb, n0, Wgu + (size_t)e * 2 * FF * DM, DM, 256 * (n0 >> 7) + (n0 & 127), 0, scr, lane, true);
    else if (which == 1) p0_transpose_item(a.in[I_WEU] + (size_t)e * DM * FF, FF, 64 * kb, n0, Wgu + (size_t)e * 2 * FF * DM, DM, 256 * (n0 >> 7) + 128 + (n0 & 127), 0, scr, lane, true);
    else                 p0_transpose_item(a.in[I_WED] + (size_t)e * FF * DM, DM, 64 * kb, n0, Wd + (size_t)e * DM * FF, FF, n0, 0, scr, lane, true);
}
constexpr int X_ITEMS = 3 * NE * 32 * 64, XE0 = X_ITEMS - 36864, XE1 = X_ITEMS - 12288;
__device__ __forceinline__ void p0_expert_range(Frame& F, const Args& a, int lo, int hi, int w, int nw) {
    const int tid = ph_tid(), lane = tid & 63; (void)lane;
    LAS float* scr = (LAS float*)(F.lds + RING_OFF + F.wave * 16384);
    for (int r = lo + w; r < hi; r += nw) p0_expert_item(a, r, scr, lane);
}
__device__ __forceinline__ void p0_weights(Frame& F, const Args& a) {
    const int tid = ph_tid(), lane = tid & 63; (void)lane;
    LAS float* scr = (LAS float*)(F.lds + RING_OFF + F.wave * 16384);
    const int gw = F.vcu * NWAVES + F.wave, NGW = F.G * NWAVES;
    bf16* Win = (bf16*)(a.ws + WS_WIN); bf16* Wab = (bf16*)(a.ws + WS_WAB); bf16* Wo = (bf16*)(a.ws + WS_WO);
    constexpr int I_IN = 32 * 320, I_A = 16 * 64, I_O = 32 * 64;
    constexpr int NX = I_IN + 2 * I_A + I_O;
    const int nitems = NX + (F.G == 256 ? XE0 : X_ITEMS);
    for (int it = gw; it < nitems; it += NGW) {
        int r = it;
        if (r < I_IN) { const int kb = r / 320, nb = r % 320; int dr = 32 * nb;
            if (dr >= 2048 && dr < 6144) { const int isb = dr >= 4096 ? 1 : 0, c = dr - 2048 - 2048 * isb; dr = 2048 + 256 * (c >> 7) + 128 * isb + (c & 127); }
            p0_transpose_item(a.in[I_WIN], PROJ, 64 * kb, 32 * nb, Win, DM, dr, 0, scr, lane, true); continue; } r -= I_IN;
        if (r < I_A) { const int kb = r / 64, nb = r % 64; p0_transpose_item(a.in[I_WA], DM, 64 * kb, 32 * nb, Wab, DM, 32 * nb, 0, scr, lane, true); continue; } r -= I_A;
        if (r < I_A) { const int kb = r / 64, nb = r % 64; p0_transpose_item(a.in[I_WB], DM, 64 * kb, 32 * nb, Wab, DM, 32 * nb, 1024, scr, lane, true); continue; } r -= I_A;
        if (r < I_O) { const int kb = r / 64, nb = r % 64; p0_transpose_item(a.in[I_WOUT], DM, 64 * kb, 32 * nb, Wo, DM, 32 * nb, 0, scr, lane, false); continue; } r -= I_O;
        p0_expert_item(a, r, scr, lane);
    }
}
__device__ __forceinline__ void p1_norm1(Frame& F, const Args& a) {
    const int tid = ph_tid(), lane = tid & 63; (void)lane;
    const int gw = F.vcu * NWAVES + F.wave, NGW = F.G * NWAVES;
    const float* mod = (const float*)(a.ws + WS_MOD); const float* g1 = a.in[I_G1]; bf16* H = (bf16*)(a.ws + WS_H);
#define P1_XROW(m) ((const GAS f32x4*)((m) < MTOK ? a.in[I_X] + (size_t)(m) * DM : a.in[I_CTX] + (size_t)((m) - MTOK) * DM) + lane)
    f32x4 v[8];
    { const GAS f32x4* xr = P1_XROW(gw < MALL ? gw : 0);
#pragma unroll
      for (int j = 0; j < 8; ++j) v[j] = xr[64 * j]; }
    for (int m = gw; m < MALL; m += NGW) {
        const float* mr = mod + (size_t)(m < MTOK ? m / SEQ : 4) * 12288;
        f32x4 g[8], sh[8], sc[8], vn[8];
#pragma unroll
        for (int j = 0; j < 8; ++j) { const int c0 = 4 * lane + 256 * j; g[j] = *(const f32x4*)(g1 + c0); sh[j] = *(const f32x4*)(mr + c0); sc[j] = *(const f32x4*)(mr + 2048 + c0); }
        { const int mn = m + NGW; const GAS f32x4* xr = P1_XROW(mn < MALL ? mn : m);
#pragma unroll
          for (int j = 0; j < 8; ++j) vn[j] = xr[64 * j]; }
        __builtin_amdgcn_sched_barrier(0);
        float s = 0.f;
#pragma unroll
        for (int j = 0; j < 8; ++j) s += (v[j].x * v[j].x + v[j].y * v[j].y) + (v[j].z * v[j].z + v[j].w * v[j].w);
        const float rstd = 1.0f / sqrtf(wave_sum(s) * (1.0f / DM) + EPS);
        GAS v2u* o8 = (GAS v2u*)(H + (size_t)m * DM) + lane;
#pragma unroll
        for (int j = 0; j < 8; ++j) { const f32x4 y = (v[j] * rstd * g[j]) * (sc[j] + 1.0f) + sh[j];
            v2u w; w.x = pk2(y.x, y.y); w.y = pk2(y.z, y.w); o8[64 * j] = w; }
#pragma unroll
        for (int j = 0; j < 8; ++j) v[j] = vn[j];
    }
#undef P1_XROW
}
__device__ __forceinline__ void p3_qknorm(Frame& F, const Args& a) {
    const int tid = ph_tid(), lane = tid & 63; (void)lane;
    LAS float* tab = (LAS float*)(F.lds + RING_OFF);
    for (int i = tid; i < 128 * 16; i += NWAVES * 64) { const int p = i >> 4, f = i & 15; const float inv = exp2f(-(float)f * (13.287712379549449f / 16.0f));
        const float ang = (float)p * inv; tab[2 * i] = cosf(ang); tab[2 * i + 1] = sinf(ang); }
    __syncthreads();
    const int gw = F.vcu * NWAVES + F.wave, NGW = F.G * NWAVES;
    constexpr int NITEM = 2 * MTOK + 2 * MALL;
    for (int it = gw; it < NITEM; it += NGW) {
        int which, row;
        if (it < MTOK) { which = 0; row = it; } else if (it < 2 * MTOK) { which = 1; row = it - MTOK; } else if (it < 2 * MTOK + MALL) { which = 2; row = it - 2 * MTOK; } else { which = 3; row = it - 2 * MTOK - MALL; }
        if (which == 1 || which == 3) continue;
        const int bufi = which == 0 ? 0 : which == 1 ? 1 : which == 2 ? 2 : 4;
        bf16* p = (bf16*)(a.ws + WS_PB + (size_t)bufi * PB_STRIDE) + (size_t)row * 1024 + 16 * lane;
        const v4u w0 = *(const GAS v4u*)p, w1 = *(const GAS v4u*)(p + 8);
        float v[16];
        v[0] = bflo(w0.x); v[1] = bfhi(w0.x); v[2] = bflo(w0.y); v[3] = bfhi(w0.y); v[4] = bflo(w0.z); v[5] = bfhi(w0.z); v[6] = bflo(w0.w); v[7] = bfhi(w0.w);
        v[8] = bflo(w1.x); v[9] = bfhi(w1.x); v[10] = bflo(w1.y); v[11] = bfhi(w1.y); v[12] = bflo(w1.z); v[13] = bfhi(w1.z); v[14] = bflo(w1.w); v[15] = bfhi(w1.w);
        float ss = 0.f;
#pragma unroll
        for (int i = 0; i < 16; ++i) ss += v[i] * v[i];
        const bool isA = (which == 0 || which == 2);
        ss += __shfl_xor(ss, 1); ss += __shfl_xor(ss, 2);
        float rstd;
        if (isA) rstd = 1.0f / sqrtf(ss * (1.0f / 64.0f) + EPS);
        else { ss += __shfl_xor(ss, 4); rstd = 1.0f / sqrtf(ss * (1.0f / 128.0f) + EPS); }
        const float* gain = a.in[which == 0 ? I_QGA : which == 1 ? I_QGB : which == 2 ? I_KGA : I_KGB] + 16 * (isA ? (lane & 3) : (lane & 7));
        const float qs = which == 0 ? 0.125f * LOG2E : which == 1 ? 0.08838834764831845f * LOG2E : 1.0f;
#pragma unroll
        for (int i = 0; i < 16; ++i) v[i] = v[i] * rstd * gain[i];
        if (isA && row < MTOK) {
            const int t = row % SEQ, j = lane & 3, pos = (j < 2) ? (t / GRIDW) : (t % GRIDW);
            const LAS float* tp = tab + pos * 32;
#pragma unroll
            for (int i = 0; i < 16; ++i) { const float other = __shfl_xor(v[i], 1); const float cs = tp[2 * i], sn = tp[2 * i + 1];
                v[i] = (j & 1) ? (v[i] * cs + other * sn) : (v[i] * cs - other * sn); }
        }
        v4u o0, o1;
        o0.x = pk2(v[0] * qs, v[1] * qs); o0.y = pk2(v[2] * qs, v[3] * qs); o0.z = pk2(v[4] * qs, v[5] * qs); o0.w = pk2(v[6] * qs, v[7] * qs);
        o1.x = pk2(v[8] * qs, v[9] * qs); o1.y = pk2(v[10] * qs, v[11] * qs); o1.z = pk2(v[12] * qs, v[13] * qs); o1.w = pk2(v[14] * qs, v[15] * qs);
        *(GAS v4u*)p = o0; *(GAS v4u*)(p + 8) = o1;
    }
    __syncthreads();
}
__device__ __forceinline__ void p7_norm2_router(Frame& F, const Args& a) {
    const int tid = ph_tid(), lane = tid & 63; (void)lane;
    typedef float f4 __attribute__((ext_vector_type(4)));
    const int gw = F.vcu * NWAVES + F.wave, NGW = F.G * NWAVES, fr = lane & 15, fq = lane >> 4;
    const float* mod = (const float*)(a.ws + WS_MOD); const float* g2 = a.in[I_G2]; const float* wr = a.in[I_WR]; const float* xn = a.out;
    const float* rowsq = (const float*)(a.ws + WS_ROWSQ); bf16* H2 = (bf16*)(a.ws + WS_H); float* aff = (float*)(a.ws + WS_AFF);
    for (int tile = gw; tile < MTOK / 16; tile += NGW) {
        const int row = tile * 16 + fr, b = (tile * 16) / SEQ;
        const float* mr = mod + (size_t)b * 12288;
        float ss = 0.f;
#pragma unroll
        for (int q = 0; q < 8; ++q) { const f4 t = *(const f4*)(rowsq + (size_t)row * 32 + 4 * q); ss += t.x; ss += t.y; ss += t.z; ss += t.w; }
        const float rstd = 1.0f / sqrtf(ss * (1.0f / DM) + EPS);
        f4 acc = {0.f, 0.f, 0.f, 0.f};
        const float* xr = xn + (size_t)row * DM + 4 * fq; bf16* hr = H2 + (size_t)row * DM + 4 * fq;
        for (int k8 = 0; k8 < DM / 16; k8 += 8) { f4 xv[8], g[8], sh[8], sc[8]; float w0[8], w1[8], w2[8], w3[8];
#pragma unroll
            for (int q = 0; q < 8; ++q) { const int kk = k8 + q, c0 = 16 * kk + 4 * fq; xv[q] = *(const f4*)(xr + 16 * kk); g[q] = *(const f4*)(g2 + c0); sh[q] = *(const f4*)(mr + 6144 + c0); sc[q] = *(const f4*)(mr + 8192 + c0);
                const float* wp = wr + (size_t)c0 * 16 + fr; w0[q] = wp[0]; w1[q] = wp[16]; w2[q] = wp[32]; w3[q] = wp[48]; }
            __builtin_amdgcn_sched_barrier(0);
#pragma unroll
            for (int q = 0; q < 8; ++q) { const int kk = k8 + q;
                const f4 hv = (xv[q] * rstd * g[q]) * (sc[q] + 1.0f) + sh[q];
                v2u w; w.x = pk2(hv.x, hv.y); w.y = pk2(hv.z, hv.w); *(GAS v2u*)(hr + 16 * kk) = w;
                acc = __builtin_amdgcn_mfma_f32_16x16x4f32(hv.x, w0[q], acc, 0, 0, 0);
                acc = __builtin_amdgcn_mfma_f32_16x16x4f32(hv.y, w1[q], acc, 0, 0, 0);
                acc = __builtin_amdgcn_mfma_f32_16x16x4f32(hv.z, w2[q], acc, 0, 0, 0);
                acc = __builtin_amdgcn_mfma_f32_16x16x4f32(hv.w, w3[q], acc, 0, 0, 0); } }
        f4 pr;
#pragma unroll
        for (int r = 0; r < 4; ++r) { float mx = acc[r];
            mx = fmaxf(mx, __shfl_xor(mx, 1)); mx = fmaxf(mx, __shfl_xor(mx, 2)); mx = fmaxf(mx, __shfl_xor(mx, 4)); mx = fmaxf(mx, __shfl_xor(mx, 8));
            const float ex = __expf(acc[r] - mx); float sm = ex;
            sm += __shfl_xor(sm, 1); sm += __shfl_xor(sm, 2); sm += __shfl_xor(sm, 4); sm += __shfl_xor(sm, 8);
            pr[r] = ex / sm; }
        const int n0 = (tile * 16) % SEQ + 4 * fq;
        *(f4*)(aff + ((size_t)(b * NE + fr)) * SEQ + n0) = pr;
    }
}
__device__ __forceinline__ void p8_topk(Frame& F, const Args& a) {
    const int tid = ph_tid(), lane = tid & 63; (void)lane;
    LAS unsigned* key = (LAS unsigned*)(F.lds + RING_OFF);
    LAS unsigned* hist = (LAS unsigned*)(F.lds + RING_OFF + 32768);
    LAS unsigned* sel = (LAS unsigned*)(F.lds + RING_OFF + 32768 + 1024);
    LAS unsigned* wsum = (LAS unsigned*)(F.lds + RING_OFF + 32768 + 2048);
    const float* aff = (const float*)(a.ws + WS_AFF); int* tok = (int*)(a.ws + WS_TOK); float* gsel = (float*)(a.ws + WS_GSEL); int* inv = (int*)(a.ws + WS_INV);
    const int wave = F.wave;
    for (int p = blockIdx.x; p < NB * NE; p += F.G) {
        const int b = p / NE, e = p % NE;
        const unsigned* src = (const unsigned*)(aff + (size_t)p * SEQ);
        for (int i = tid; i < SEQ; i += NWAVES * 64) key[i] = src[i];
        unsigned prefix = 0u, mask = 0u, krem = CAP;
        for (int pass = 0; pass < 4; ++pass) {
            const int shift = 24 - 8 * pass;
            if (tid < 256) hist[tid] = 0u;
            __syncthreads();
            for (int i = tid; i < SEQ; i += NWAVES * 64) { const unsigned k = key[i]; if ((k & mask) == prefix) atomicAdd((unsigned*)&hist[(k >> shift) & 255u], 1u); }
            __syncthreads();
            if (wave == 0) {
                unsigned h0 = hist[255 - 4 * lane], h1 = hist[254 - 4 * lane], h2 = hist[253 - 4 * lane], h3 = hist[252 - 4 * lane];
                const unsigned s = h0 + h1 + h2 + h3; unsigned inc = s;
#pragma unroll
                for (int o = 1; o < 64; o <<= 1) { const unsigned t = __shfl_up(inc, o); if (lane >= o) inc += t; }
                const unsigned exc = inc - s;
                if (exc < krem && krem <= inc) {
                    unsigned r = krem - exc; int bin;
                    if (r <= h0) bin = 255 - 4 * lane; else { r -= h0; if (r <= h1) bin = 254 - 4 * lane; else { r -= h1; if (r <= h2) bin = 253 - 4 * lane; else { r -= h2; bin = 252 - 4 * lane; } } }
                    sel[0] = (unsigned)bin; sel[1] = r; }
            }
            __syncthreads();
            prefix |= sel[0] << shift; mask |= 255u << shift; krem = sel[1];
            __syncthreads();
        }
        const unsigned T = prefix;
        unsigned cgt = 0u, ceq = 0u; unsigned kk[16];
#pragma unroll
        for (int i = 0; i < 16; ++i) { kk[i] = key[16 * tid + i]; cgt += kk[i] > T ? 1u : 0u; ceq += kk[i] == T ? 1u : 0u; }
        const unsigned pk = cgt | (ceq << 16); unsigned inc = pk;
#pragma unroll
        for (int o = 1; o < 64; o <<= 1) { const unsigned t = __shfl_up(inc, o); if (lane >= o) inc += t; }
        if (lane == 63) wsum[wave] = inc;
        __syncthreads();
        unsigned base = 0u;
        for (int w = 0; w < wave; ++w) base += wsum[w];
        const unsigned exc = base + inc - pk; unsigned ngt = exc & 0xffffu, neq = exc >> 16;
#pragma unroll
        for (int i = 0; i < 16; ++i) { const int n = 16 * tid + i; int slot = -1;
            if (kk[i] > T) { slot = (int)(ngt + (neq < krem ? neq : krem)); ++ngt; }
            else if (kk[i] == T) { if (neq < krem) slot = (int)(ngt + neq); ++neq; }
            inv[((size_t)b * SEQ + n) * NE + e] = slot;
            if (slot >= 0) { tok[(size_t)p * CAP + slot] = b * SEQ + n; gsel[(size_t)p * CAP + slot] = __uint_as_float(kk[i]); } }
        __syncthreads();
    }
}
__device__ __forceinline__ void p9_gather(Frame& F, const Args& a) {
    const int tid = ph_tid(), lane = tid & 63; (void)lane;
    const int gw = F.vcu * NWAVES + F.wave, NGW = F.G * NWAVES;
    const int* tok = (const int*)(a.ws + WS_TOK); const bf16* H2 = (const bf16*)(a.ws + WS_H); bf16* XE = (bf16*)(a.ws + WS_XE);
    for (int s = gw; s < MSLOT; s += NGW) { int sv = s; asm volatile("" : "+v"(sv)); const int t = tok[sv];
        const GAS v4u* src = (const GAS v4u*)(H2 + (size_t)t * DM) + lane; GAS v4u* dst = (GAS v4u*)(XE + (size_t)s * DM) + lane;
        const v4u v0 = src[0], v1 = src[64], v2 = src[128], v3 = src[192]; dst[0] = v0; dst[64] = v1; dst[128] = v2; dst[192] = v3; }
}
__device__ __forceinline__ void p12_combine(Frame& F, const Args& a) {
    const int tid = ph_tid(), lane = tid & 63; (void)lane;
    const int gw = F.vcu * NWAVES + F.wave, NGW = F.G * NWAVES;
    const int* inv = (const int*)(a.ws + WS_INV); const bf16* YM = (const bf16*)(a.ws + WS_XE); float* out = a.out;
    int myslot = -1, nslot = -1; f32x4 acc[8];
    if (gw < MTOK) myslot = inv[(size_t)gw * NE + (lane & 15)];
    if (gw + NGW < MTOK) nslot = inv[(size_t)(gw + NGW) * NE + (lane & 15)];
    if (gw < MTOK && (__ballot(myslot >= 0) & 0xffffull) != 0ull) {
#pragma unroll
        for (int j = 0; j < 8; ++j) acc[j] = *(const GAS f32x4*)(out + (size_t)gw * DM + 4 * lane + 256 * j); }
    for (int m = gw; m < MTOK; m += NGW) {
        const int b = m / SEQ; const int mn = m + NGW, mnn = m + 2 * NGW;
        int nnslot = -1; if (mnn < MTOK) nnslot = inv[(size_t)mnn * NE + (lane & 15)];
        f32x4 accn[8];
        const bool nneed = (__ballot(nslot >= 0) & 0xffffull) != 0ull;
        if (nneed) {
#pragma unroll
            for (int j = 0; j < 8; ++j) accn[j] = *(const GAS f32x4*)(out + (size_t)mn * DM + 4 * lane + 256 * j); }
        __builtin_amdgcn_sched_barrier(0);
        unsigned mask = (unsigned)(__ballot(myslot >= 0) & 0xffffull);
        const bool need = mask != 0u;
        while (mask) {
            const int e1 = __builtin_ctz(mask); mask &= mask - 1; const bool two = mask != 0u; const int e2 = two ? __builtin_ctz(mask) : e1; if (two) mask &= mask - 1;
            const int s1 = __shfl(myslot, e1), s2 = __shfl(myslot, e2);
            const bf16* y1 = YM + ((size_t)(b * NE + e1) * CAP + s1) * DM + 4 * lane; const bf16* y2 = YM + ((size_t)(b * NE + e2) * CAP + s2) * DM + 4 * lane;
            v2u w1[8], w2[8];
#pragma unroll
            for (int j = 0; j < 8; ++j) { w1[j] = *(const GAS v2u*)(y1 + 256 * j); w2[j] = *(const GAS v2u*)(y2 + 256 * j); }
            __builtin_amdgcn_sched_barrier(0);
#pragma unroll
            for (int j = 0; j < 8; ++j) { acc[j].x += bflo(w1[j].x); acc[j].y += bfhi(w1[j].x); acc[j].z += bflo(w1[j].y); acc[j].w += bfhi(w1[j].y);
                if (two) { acc[j].x += bflo(w2[j].x); acc[j].y += bfhi(w2[j].x); acc[j].z += bflo(w2[j].y); acc[j].w += bfhi(w2[j].y); } }
        }
        if (need) {
#pragma unroll
            for (int j = 0; j < 8; ++j) *(GAS f32x4*)(out + (size_t)m * DM + 4 * lane + 256 * j) = acc[j]; }
        myslot = nslot; nslot = nnslot;
        if (nneed) {
#pragma unroll
            for (int j = 0; j < 8; ++j) acc[j] = accn[j]; }
    }
}

__global__ void __launch_bounds__(NWAVES * 64, 2) fwd_kernel(Args args) {
    extern __shared__ __attribute__((aligned(16))) unsigned char lds[];
    Frame F;
    F.lds = (LAS unsigned char*)lds;
    F.MISC = (volatile LAS unsigned*)(F.lds + MISC_OFF);
    F.wave = __builtin_amdgcn_readfirstlane(threadIdx.x >> 6);
    F.G = gridDim.x; { const int bx = blockIdx.x; F.vcu = (F.G % 8 == 0) ? (bx % 8) * (F.G / 8) + bx / 8 : bx; }
    unsigned char* ws = args.ws;
    F.ctl = (gu32*)(ws + WS_CTL);
    for (int u = threadIdx.x; u < (LDS_BYTES - LDSCTL_OFF) / 4; u += NWAVES * 64) ((LAS unsigned*)(F.lds + LDSCTL_OFF))[u] = 0u;
    __syncthreads();
    XcdBarrier bar; bar.bar = (unsigned*)(F.ctl + CW_BAR); bar.x = 0; bar.st = nullptr;
    if (N_LAUNCHES != PER_PHASE) bar = xcd_barrier_post((unsigned*)(F.ctl + CW_BAR), F.MISC + 8);
#define GRID_BAR(seam) do { if (N_LAUNCHES == PER_PHASE) { if (threadIdx.x == 0) __hip_atomic_store(F.ctl + CW_TMO, 0xBADBA0u | (unsigned)(seam), RLX_AGENT); } else { xcd_barrier(bar); } } while (0)
    const int lo = args.ph_lo, hi = args.ph_hi;
#ifdef ONLY_PHASE
#define IN(k) ((k) == ONLY_PHASE && lo <= (k) && (k) < hi)
#else
#define IN(k) (lo <= (k) && (k) < hi)
#endif
#define BOTH(k) (IN(k) && IN((k) + 1))
    float* mod = (float*)(ws + WS_MOD);
    bf16* PB = (bf16*)(ws + WS_PB); constexpr size_t PBS = PB_STRIDE / 2;

    if (IN(0)) {
        if (blockIdx.x == 0) { float* rt = (float*)(ws + WS_ROPE);
            for (int i = threadIdx.x; i < 128 * 16; i += NWAVES * 64) { const int p = i >> 4, f = i & 15; const float inv = exp2f(-(float)f * (13.287712379549449f / 16.0f));
                const float ang = (float)p * inv; rt[2 * i] = cosf(ang); rt[2 * i + 1] = sinf(ang); }
            float* gn = (float*)(ws + WS_GAINS);
            if (threadIdx.x < 64) { gn[threadIdx.x] = args.in[I_QGA][threadIdx.x]; gn[256 + threadIdx.x] = args.in[I_KGA][threadIdx.x]; }
            if (threadIdx.x < 128) { gn[128 + threadIdx.x] = args.in[I_QGB][threadIdx.x]; gn[384 + threadIdx.x] = args.in[I_KGB][threadIdx.x]; } }
        p0_mod(F, args, mod); p0_weights(F, args); if (BOTH(0)) GRID_BAR(0); }
    if (IN(1)) { p1_norm1(F, args); if (BOTH(1)) GRID_BAR(1); }
    if (IN(2)) {
        pg8::Gemm g{(const bf16*)(ws + WS_H), (const bf16*)(ws + WS_WIN), MALL, PROJ, DM}; pg8::ProjOrder S; S.init(F.G, (int)blockIdx.x);
        pg8::EpiProj E{PB, PBS, (bf16*)(ws + WS_GATE), (LAS float*)(F.lds + EPI_X_OFF), (const float*)(ws + WS_GAINS), (const float*)(ws + WS_ROPE)};
        pg8::gemm_phase<pg8::EpiProj, pg8::ProjOrder, true, true>(F.lds + RING_OFF, g, S, E);
        if (F.G == 256 && blockIdx.x >= 64) { __syncthreads(); p0_expert_range(F, args, XE0, XE1, ((int)blockIdx.x - 64) * NWAVES + F.wave, 192 * NWAVES); }
        if (BOTH(2)) GRID_BAR(2);
    }
#if !FUSE_A
    if (IN(3)) { p3_qknorm(F, args); if (BOTH(3)) GRID_BAR(3); }
#endif
    if (IN(4)) {
        float lam;
        { const float* q1 = args.in[I_LQ1]; const float* k1 = args.in[I_LK1]; const float* q2 = args.in[I_LQ2]; const float* k2 = args.in[I_LK2];
          const int lane = ph_tid() & 63; const float s1 = wave_sum(q1[lane] * k1[lane]), s2 = wave_sum(q2[lane] * k2[lane]); lam = expf(s1) - expf(s2) + 0.2f; }
        bf16* Y = (bf16*)(ws + WS_H);
        const int bx = blockIdx.x;
        if (F.G == 256) {
            const int x = bx & 7, j = bx >> 3;
#ifndef NO_DIFF
            for (int i = 0; i < 8; ++i) att::diff_unit((x * 4 + (i >> 1)) >> 3, (x * 4 + (i >> 1)) & 7, (i & 1) * 32 + j, PB, PB + 2 * PBS, PB + 3 * PBS, Y, lam, args.in[I_SUBLN], (char*)lds + RING_OFF, F.lds + RING_OFF);
#endif
#ifndef NO_NA
            for (int i = 0; i < 4; ++i) att::na_unit((x * 4 + i) >> 3, (x * 4 + i) & 7, j, PB + PBS, PB + 4 * PBS, PB + 5 * PBS, Y, args.in[I_RPB], (char*)lds + RING_OFF);
#endif
        } else {
#ifndef NO_DIFF
            for (int uu = bx; uu < 2048; uu += F.G) att::diff_unit((uu >> 6) >> 3, (uu >> 6) & 7, uu & 63, PB, PB + 2 * PBS, PB + 3 * PBS, Y, lam, args.in[I_SUBLN], (char*)lds + RING_OFF, F.lds + RING_OFF);
#endif
#ifndef NO_NA
            for (int uu = bx; uu < 1024; uu += F.G) att::na_unit((uu >> 5) >> 3, (uu >> 5) & 7, uu & 31, PB + PBS, PB + 4 * PBS, PB + 5 * PBS, Y, args.in[I_RPB], (char*)lds + RING_OFF);
#endif
        }
        if (BOTH(4)) GRID_BAR(4);
    }
    if (IN(5)) {
        pg8::Gemm g{(const bf16*)(ws + WS_H), (const bf16*)(ws + WS_WAB), MTOK, DM, DM}; pg8::StaticOrder S; S.init(MTOK, DM, F.G, (int)blockIdx.x);
        pg8::EpiMerge E{(const bf16*)(ws + WS_GATE), (bf16*)(ws + WS_U)};
        pg8::gemm_phase<pg8::EpiMerge, pg8::StaticOrder, true, true>(F.lds + RING_OFF, g, S, E);
        if (BOTH(5)) GRID_BAR(5);
    }
    if (IN(6)) {
        pg8::Gemm g{(const bf16*)(ws + WS_U), (const bf16*)(ws + WS_WO), MTOK, DM, DM, UP}; pg8::StaticOrder S; S.init(MTOK, DM, F.G, (int)blockIdx.x);
        if (F.G == 256) {
            pg8::EpiWoDrain Ed{args.in[I_X], mod, args.out, (float*)(ws + WS_ROWSQ)}; pg8::OneUnitOrder S1; S1.so = S;
#define X_PREFETCH(w) do { pg8::Unit u_; S1.which = (w); if (S1.next(0, u_)) { const int t_ = ph_tid(); const float* xt_ = args.in[I_X] + (size_t)u_.pm * 256 * DM + (size_t)u_.pn * 256; \
        _Pragma("unroll") for (int k_ = 0; k_ < 4; ++k_) { const int L_ = t_ + 512 * k_; \
            __builtin_amdgcn_global_load_lds((const unsigned*)(xt_ + (size_t)(L_ >> 3) * DM + (L_ & 7) * 32), (LAS unsigned*)(F.lds + 144384 + F.wave * 256), 4, 0, 0); } } } while (0)
            X_PREFETCH(0); S1.which = 0; pg8::gemm_phase<pg8::EpiWoDrain, pg8::OneUnitOrder, false, true>(F.lds + RING_OFF, g, S1, Ed); __syncthreads();
            X_PREFETCH(1); S1.which = 1; pg8::gemm_phase<pg8::EpiWoDrain, pg8::OneUnitOrder, false, true>(F.lds + RING_OFF, g, S1, Ed); __syncthreads();
            X_PREFETCH(2); S1.which = 2; pg8::gemm_phase<pg8::EpiWoDrain, pg8::OneUnitOrder, false, true>(F.lds + RING_OFF, g, S1, Ed); __syncthreads();
            X_PREFETCH(3); S1.which = 3; pg8::gemm_phase<pg8::EpiWoDrain, pg8::OneUnitOrder, false, true>(F.lds + RING_OFF, g, S1, Ed); __syncthreads();
#undef X_PREFETCH
        } else {
        pg8::EpiWo E{args.in[I_X], mod, args.out, (float*)(ws + WS_ROWSQ)};
        pg8::gemm_phase<pg8::EpiWo, pg8::StaticOrder, true, true>(F.lds + RING_OFF, g, S, E);
        }
        if (BOTH(6)) GRID_BAR(6);
    }
    if (IN(7)) { p7_norm2_router(F, args); if (BOTH(7)) GRID_BAR(7); }
    if (IN(8)) { p8_topk(F, args); if (F.G == 256 && blockIdx.x >= 64) p0_expert_range(F, args, XE1, X_ITEMS, ((int)blockIdx.x - 64) * NWAVES + F.wave, 192 * NWAVES); if (BOTH(8)) GRID_BAR(8); }
    if (IN(10)) {
        pg8::Gemm g{(const bf16*)(ws + WS_H), (const bf16*)(ws + WS_WGU), MSLOT, 2 * FF, DM}; pg8::ExpertGatherOrder S; S.init(MSLOT, 2 * FF, F.G, (int)blockIdx.x); S.estride = (size_t)2 * FF * DM * 2; S.rowmap = (const int*)(ws + WS_TOK);
        pg8::EpiSwiglu E{(bf16*)(ws + WS_GATE)};
        pg8::gemm_phase<pg8::EpiSwiglu, pg8::ExpertGatherOrder, true, true>(F.lds + RING_OFF, g, S, E);
        if (BOTH(10)) GRID_BAR(10);
    }
    if (IN(11)) {
        pg8::Gemm g{(const bf16*)(ws + WS_GATE), (const bf16*)(ws + WS_WD), MSLOT, DM, FF}; pg8::ExpertOrder S; S.init(MSLOT, DM, F.G, (int)blockIdx.x); S.estride = (size_t)DM * FF * 2;
        pg8::EpiDown E{(const float*)(ws + WS_GSEL), mod, (bf16*)(ws + WS_XE)};
        pg8::gemm_phase<pg8::EpiDown, pg8::ExpertOrder, true, true>(F.lds + RING_OFF, g, S, E);
        if (BOTH(11)) GRID_BAR(11);
    }
    if (IN(12)) { p12_combine(F, args); }
#undef IN
#undef BOTH
}

extern "C" void kernel_launch(void* const* d_in, const int* in_sizes, int n_in, void* d_out, int out_size, void* d_ws, size_t ws_size, hipStream_t stream) {
    static int grid = 0;
    if (grid == 0) {
        if (n_in != 26 || in_sizes[0] != MTOK * DM || out_size != MTOK * DM || ws_size < WS_END) { fprintf(stderr, "kernel_launch: shape mismatch: n_in %d in0 %d out %d ws %zu (need %zu); nothing launched\n", n_in, n_in > 0 ? in_sizes[0] : -1, out_size, ws_size, (size_t)WS_END); grid = -1; return; }
        int dev = 0, cus = 0, per_cu = 0;
        if (hipGetDevice(&dev) != hipSuccess || hipDeviceGetAttribute(&cus, hipDeviceAttributeMultiprocessorCount, dev) != hipSuccess) { fprintf(stderr, "kernel_launch: device query failed\n"); grid = -1; return; }
        if (hipFuncSetAttribute((const void*)fwd_kernel, hipFuncAttributeMaxDynamicSharedMemorySize, LDS_BYTES) != hipSuccess) { fprintf(stderr, "kernel_launch: hipFuncSetAttribute failed\n"); grid = -1; return; }
        if (hipOccupancyMaxActiveBlocksPerMultiprocessor(&per_cu, (const void*)fwd_kernel, NWAVES * 64, LDS_BYTES) != hipSuccess || per_cu < 1)
            fprintf(stderr, "kernel_launch: note: occupancy query reports %d workgroups per CU\n", per_cu);
        (void)hipGetLastError();
        grid = cus;
    }
    if (grid < 0) return;
    if (hipMemsetAsync((char*)d_ws + WS_CTL, 0, CTL_ZERO_BYTES, stream) != hipSuccess) { fprintf(stderr, "kernel_launch: memset failed\n"); return; }
    Args a{};
    for (int i = 0; i < 26; ++i) a.in[i] = (const float*)d_in[i];
    a.out = (float*)d_out; a.ws = (unsigned char*)d_ws; a.pad = 0;
    for (int li = 0; li < N_LAUNCHES; ++li) {
        a.ph_lo = (N_LAUNCHES == PER_PHASE) ? li : 0; a.ph_hi = (N_LAUNCHES == PER_PHASE) ? li + 1 : PER_PHASE; a.li = li;
        hipLaunchKernelGGL(fwd_kernel, dim3(grid), dim3(NWAVES * 64), LDS_BYTES, stream, a);
        const hipError_t le = hipPeekAtLastError();
        if (le != hipSuccess) { fprintf(stderr, "kernel_launch: launch %d failed: %s\n", li, hipGetErrorName(le)); break; }
    }
}
```

```cpp
#include <hip/hip_runtime.h>
#include <cstdio>
#include <cstdint>

#ifndef MK_N_LAUNCHES
#define MK_N_LAUNCHES 1
#endif

constexpr int DM = 2048, NB = 4, SEQ = 8192, MTOK = NB * SEQ, CTXL = 256, MCTX = NB * CTXL, MALL = MTOK + MCTX;
constexpr int PROJ = 10240, NE = 16, FF = 2048, CAP = 1024, MSLOT = NB * NE * CAP;
constexpr int GRIDW = 64, GROWS = SEQ / GRIDW;
constexpr float EPS = 1e-6f;
constexpr int UP = DM + 64;
constexpr float LOG2E = 1.4426950408889634f;

namespace pg8 {
#define PG8_LAS __attribute__((address_space(3)))
typedef unsigned short bf16_t;
typedef short bf16x8 __attribute__((ext_vector_type(8)));
typedef float f32x4 __attribute__((ext_vector_type(4)));
typedef unsigned u32x4 __attribute__((ext_vector_type(4)));
typedef unsigned u32x2 __attribute__((ext_vector_type(2)));
constexpr int BM = 256, BK = 64, HALF = 128, HTB = HALF * BK * 2  , STAGE_BYTES = 8 * HTB, NXCD = 8, WGM = 8;

__host__ __device__ __forceinline__ int lds_byte(int r, int c) { const int st = (r >> 4) * 2 + (c >> 5), rr = r & 15, cc = c & 31, ob = rr * 64 + cc * 2; return st * 1024 + (ob ^ (((ob >> 9) & 1) << 5)); }
__host__ __device__ __forceinline__ void stage_rc(int b, int& R, int& C) { const int st = b / 1024, sb = b % 1024, swz = sb ^ (((sb >> 9) & 1) << 5); R = (st >> 1) * 16 + swz / 64; C = (st & 1) * 32 + (swz % 64) / 2; }
__host__ __device__ __forceinline__ int perm32(int rho) { const int n = rho >> 4, i = rho & 15; return 8 * (i >> 2) + 4 * n + (i & 3); }

struct Unit { int pm, pn; };
struct Gemm { const bf16_t* A; const bf16_t* Bt; int M, N, K; int lda = 0; };

struct StaticOrder {
    int nM, nN, nwg, G, c;
    __host__ __device__ void init(int M, int N, int G_, int c_) { nM = M / BM; nN = N / BM; nwg = nM * nN; G = G_; c = c_; }
    __host__ __device__ bool next(int i, Unit& u) const {
        const long L = (long)i * G + c; if (L >= nwg) return false;
        int wgid = (int)L; { const int q = nwg / NXCD, r = nwg % NXCD, xcd = wgid % NXCD, off = wgid / NXCD; wgid = (xcd < r ? xcd * (q + 1) : r * (q + 1) + (xcd - r) * q) + off; }
        const int nig = WGM * nN, gid = wgid / nig, fm = gid * WGM, gsz = (nM - fm) < WGM ? (nM - fm) : WGM;
        u.pm = fm + ((wgid % nig) % gsz); u.pn = (wgid % nig) / gsz;
        u.pn = (u.pn + (int)(L % NXCD) * nN / NXCD) % nN;
        return true;
    }
    __device__ __forceinline__ void a_ready(const Unit&) const {}
    __device__ __forceinline__ void done(const Unit&) const {}
    __device__ __forceinline__ size_t bofs(const Unit&) const { return 0; }
    static constexpr bool GATHER = false;
};
struct ProjOrder {
    StaticOrder so;
    __device__ void init(int G_, int c_) { so.init(MTOK, PROJ, G_, c_); }
    __device__ bool next(int i, Unit& u) const {
        if (so.next(i, u)) return true;
        const long j = (long)i * so.G + so.c - so.nwg; if (j < 0 || j >= 64) return false;
        u.pm = MTOK / BM + (int)(j >> 4); u.pn = 24 + (int)(j & 15); return true;
    }
    __device__ __forceinline__ void a_ready(const Unit&) const {}
    __device__ __forceinline__ void done(const Unit&) const {}
    __device__ __forceinline__ size_t bofs(const Unit&) const { return 0; }
    static constexpr bool GATHER = false;
};
struct OneUnitOrder {
    StaticOrder so; int which;
    __device__ bool next(int i, Unit& u) const { return i == 0 && so.next(which, u); }
    __device__ __forceinline__ void a_ready(const Unit&) const {}
    __device__ __forceinline__ void done(const Unit&) const {}
    __device__ __forceinline__ size_t bofs(const Unit&) const { return 0; }
    static constexpr bool GATHER = false;
};
struct ExpertOrder : StaticOrder {
    size_t estride;
    __device__ __forceinline__ size_t bofs(const Unit& u) const { return (size_t)((u.pm >> 2) & 15) * estride; }
};
struct ExpertGatherOrder : ExpertOrder {
    const int* rowmap;
    static constexpr bool GATHER = true;
};

typedef float f32x2_cv __attribute__((ext_vector_type(2))); typedef __bf16 bf16x2_cv __attribute__((ext_vector_type(2)));
__device__ __forceinline__ unsigned cvt_pk_bf16(float lo, float hi) { const f32x2_cv v = {lo, hi}; const bf16x2_cv b = __builtin_convertvector(v, bf16x2_cv); return __builtin_bit_cast(unsigned, b); }
__device__ __forceinline__ float bf_lo(unsigned w) { return __uint_as_float(w << 16); }
__device__ __forceinline__ float bf_hi(unsigned w) { return __uint_as_float(w & 0xffff0000u); }
__device__ __forceinline__ float sigmoidf_(float v) { return __builtin_amdgcn_rcpf(1.0f + __builtin_amdgcn_exp2f(-v * LOG2E)); }


#ifndef FUSE_A
#define FUSE_A 1
#endif
__device__ __forceinline__ size_t gate_off(int pm, int pg, int wave, int lane) { return ((((size_t)pm * 16 + pg) * 8 + wave) * 16) * 512 + (size_t)lane * 8; }
struct EpiProj {
    static constexpr bool PERM = true, AFTER_DRAIN = false, HAS_MID = false;
    bf16_t* pb; size_t pbs; bf16_t* gate;
    PG8_LAS float* X;
    const float* gains; const float* rtab;
    __device__ __forceinline__ void normed(const f32x4 (&acc)[2][2][4][2], const Unit& u, int wr, int wc, int fr, int fq, bf16_t* base, int colt, bool isA, bool isQ) const {
        const int rl0 = wr * 64 + fr;
#pragma unroll
        for (int ai = 0; ai < 2; ++ai)
#pragma unroll
            for (int m = 0; m < 4; ++m)
#pragma unroll
                for (int bj = 0; bj < 2; ++bj) { const f32x4 a0 = acc[ai][bj][m][0], a1 = acc[ai][bj][m][1];
                    float sq = ((a0[0] * a0[0] + a0[1] * a0[1]) + (a0[2] * a0[2] + a0[3] * a0[3])) + ((a1[0] * a1[0] + a1[1] * a1[1]) + (a1[2] * a1[2] + a1[3] * a1[3]));
                    sq += __shfl_xor(sq, 16); sq += __shfl_xor(sq, 32);
                    if (fq == 0) X[((rl0 + ai * HALF + m * 16) * 2 + bj) * 4 + wc] = sq; }
        asm volatile("s_waitcnt lgkmcnt(0)" ::: "memory"); __builtin_amdgcn_s_barrier(); asm volatile("" ::: "memory");
        const float* gain = gains + (isQ ? 0 : 256) + (isA ? 0 : 128);
        const int gd = (isA ? 32 * (wc & 1) : 32 * wc) + 8 * fq;
        const f32x4 g0 = *(const f32x4*)(gain + gd), g1 = *(const f32x4*)(gain + gd + 4);
        const float qs = isQ ? (isA ? 0.125f * LOG2E : 0.08838834764831845f * LOG2E) : 1.0f;
        const int row0 = u.pm * BM + rl0, col0 = colt + wc * 32 + 8 * fq;
        const bool rope = FUSE_A && isA && (u.pm < MTOK / BM);
#pragma unroll
        for (int ai = 0; ai < 2; ++ai)
#pragma unroll
            for (int m = 0; m < 4; ++m) { const int rl = rl0 + ai * HALF + m * 16, row = row0 + ai * HALF + m * 16; bf16_t* rowp = base + (size_t)row * 1024 + col0;
                f32x4 c0 = {1.f, 1.f, 1.f, 1.f}, s0 = {0.f, 0.f, 0.f, 0.f}, c1 = c0, s1 = s0;
                if (rope) { const int t = row % SEQ, pos = (wc & 1) ? (t % GRIDW) : (t / GRIDW); const float* tp = rtab + pos * 32 + 2 * (8 * (fq & 1));
                    const f32x4 t0 = *(const f32x4*)tp, t1 = *(const f32x4*)(tp + 4), t2 = *(const f32x4*)(tp + 8), t3 = *(const f32x4*)(tp + 12);
                    c0 = (f32x4){t0[0], t0[2], t1[0], t1[2]}; s0 = (f32x4){t0[1], t0[3], t1[1], t1[3]}; c1 = (f32x4){t2[0], t2[2], t3[0], t3[2]}; s1 = (f32x4){t2[1], t2[3], t3[1], t3[3]};
                    if (fq < 2) { s0 = -s0; s1 = -s1; } }
#pragma unroll
                for (int bj = 0; bj < 2; ++bj) { const PG8_LAS float* xp = X + (rl * 2 + bj) * 4;
                    const float tot = isA ? (xp[wc & ~1] + xp[wc | 1]) : (((xp[0] + xp[1]) + xp[2]) + xp[3]);
                    const float rstd = __builtin_amdgcn_rsqf(tot * (isA ? (1.0f / 64.0f) : (1.0f / 128.0f)) + EPS);
                    f32x4 v0 = acc[ai][bj][m][0] * rstd * g0, v1 = acc[ai][bj][m][1] * rstd * g1;
                    if (rope) { f32x4 o0, o1;
#pragma unroll
                        for (int e = 0; e < 4; ++e) { o0[e] = __shfl_xor(v0[e], 32); o1[e] = __shfl_xor(v1[e], 32); }
                        v0 = v0 * c0 + o0 * s0; v1 = v1 * c1 + o1 * s1; }
                    v0 = v0 * qs; v1 = v1 * qs;
                    u32x4 w; w.x = cvt_pk_bf16(v0[0], v0[1]); w.y = cvt_pk_bf16(v0[2], v0[3]); w.z = cvt_pk_bf16(v1[0], v1[1]); w.w = cvt_pk_bf16(v1[2], v1[3]);
                    *(u32x4*)(rowp + bj * HALF) = w; } }
    }
    __device__ __forceinline__ void operator()(const f32x4 (&acc)[2][2][4][2], const Unit& u, int wr, int wc, int fr, int fq) const {
        const int pn = u.pn; bf16_t* base; int ldc, colt; bool sig = false;
        if (pn < 8) { base = pb + (size_t)(pn >> 2) * pbs; colt = (pn & 3) * BM; ldc = 1024; }
        else if (pn < 24) { base = gate; colt = (pn - 8) * BM; ldc = 4096; sig = true; }
        else { base = pb + (size_t)(2 + ((pn - 24) >> 2)) * pbs; colt = ((pn - 24) & 3) * BM; ldc = 1024; }
        const bool isB = (pn >= 4 && pn < 8) || (pn >= 32 && pn < 36), isA = FUSE_A && (pn < 4 || (pn >= 24 && pn < 28));
        if (isA || isB) { normed(acc, u, wr, wc, fr, fq, base, colt, isA, pn < 8); return; }
        if (sig) {
            bf16_t* gp = gate + gate_off(u.pm, pn - 8, wr * 4 + wc, (fq << 4) | fr);
#pragma unroll
            for (int ai = 0; ai < 2; ++ai)
#pragma unroll
                for (int m = 0; m < 4; ++m) { f32x4 ra[2], sb[2];
#pragma unroll
                    for (int n = 0; n < 2; ++n)
#pragma unroll
                        for (int e = 0; e < 4; ++e) {
                            const float ea = 1.0f + __builtin_amdgcn_exp2f(fminf(-acc[ai][0][m][n][e] * LOG2E, 50.0f)), eb = 1.0f + __builtin_amdgcn_exp2f(fminf(-acc[ai][1][m][n][e] * LOG2E, 50.0f));
                            const float inv = __builtin_amdgcn_rcpf(ea * eb); sb[n][e] = inv * ea; ra[n][e] = eb * eb * inv; }
                    u32x4 w; w.x = cvt_pk_bf16(ra[0][0], ra[0][1]); w.y = cvt_pk_bf16(ra[0][2], ra[0][3]); w.z = cvt_pk_bf16(ra[1][0], ra[1][1]); w.w = cvt_pk_bf16(ra[1][2], ra[1][3]);
                    *(u32x4*)(gp + (ai * 4 + m) * 512) = w;
                    w.x = cvt_pk_bf16(sb[0][0], sb[0][1]); w.y = cvt_pk_bf16(sb[0][2], sb[0][3]); w.z = cvt_pk_bf16(sb[1][0], sb[1][1]); w.w = cvt_pk_bf16(sb[1][2], sb[1][3]);
                    *(u32x4*)(gp + (8 + ai * 4 + m) * 512) = w; }
            return; }
        const int row0 = u.pm * BM + wr * 64 + fr, col0 = colt + wc * 32 + 8 * fq;
#pragma unroll
        for (int ai = 0; ai < 2; ++ai)
#pragma unroll
            for (int m = 0; m < 4; ++m) { bf16_t* rowp = base + (size_t)(row0 + ai * HALF + m * 16) * ldc + col0;
#pragma unroll
                for (int bj = 0; bj < 2; ++bj) { const f32x4 v0 = acc[ai][bj][m][0], v1 = acc[ai][bj][m][1];
                    u32x4 w; w.x = cvt_pk_bf16(v0[0], v0[1]); w.y = cvt_pk_bf16(v0[2], v0[3]); w.z = cvt_pk_bf16(v1[0], v1[1]); w.w = cvt_pk_bf16(v1[2], v1[3]);
                    *(u32x4*)(rowp + bj * HALF) = w; } }
    }
};
struct EpiMerge {
    static constexpr bool PERM = true, AFTER_DRAIN = false, HAS_MID = true;
    const bf16_t* gate; bf16_t* U;
    __device__ __forceinline__ void mid(f32x4 (&acc)[2][2][4][2], const Unit& u, int wr, int wc, int fr, int fq) const {
        int ln = (fq << 4) | fr; asm volatile("" : "+v"(ln));
        const bf16_t* gp0 = gate + gate_off(u.pm, 2 * u.pn, wr * 4 + wc, ln); const bf16_t* gp1 = gate + gate_off(u.pm, 2 * u.pn + 1, wr * 4 + wc, ln);
        u32x4 r[2][4][2];
#pragma unroll
        for (int ai = 0; ai < 2; ++ai)
#pragma unroll
            for (int m = 0; m < 4; ++m) { r[ai][m][0] = *(const u32x4*)(gp0 + (ai * 4 + m) * 512); r[ai][m][1] = *(const u32x4*)(gp1 + (ai * 4 + m) * 512); }
#pragma unroll
        for (int ai = 0; ai < 2; ++ai)
#pragma unroll
            for (int m = 0; m < 4; ++m)
#pragma unroll
                for (int bj = 0; bj < 2; ++bj) { const u32x4 a = r[ai][m][bj];
                    const f32x4 r0 = {bf_lo(a.x), bf_hi(a.x), bf_lo(a.y), bf_hi(a.y)}, r1 = {bf_lo(a.z), bf_hi(a.z), bf_lo(a.w), bf_hi(a.w)};
                    acc[ai][bj][m][0] *= r0; acc[ai][bj][m][1] *= r1; }
        asm volatile("" ::: "memory");
    }
    __device__ __forceinline__ void operator()(const f32x4 (&acc)[2][2][4][2], const Unit& u, int wr, int wc, int fr, int fq) const {
        int row0 = u.pm * BM + wr * 64 + fr, col0 = u.pn * BM + wc * 32 + 8 * fq; asm volatile("" : "+v"(row0), "+v"(col0));
        u32x4 gb[2][4][2]; const int ln = (fq << 4) | fr;
        const bf16_t* gp0 = gate + gate_off(u.pm, 2 * u.pn, wr * 4 + wc, ln); const bf16_t* gp1 = gate + gate_off(u.pm, 2 * u.pn + 1, wr * 4 + wc, ln);
#pragma unroll
        for (int ai = 0; ai < 2; ++ai)
#pragma unroll
            for (int m = 0; m < 4; ++m) { gb[ai][m][0] = *(const u32x4*)(gp0 + (8 + ai * 4 + m) * 512); gb[ai][m][1] = *(const u32x4*)(gp1 + (8 + ai * 4 + m) * 512); }
#pragma unroll
        for (int ai = 0; ai < 2; ++ai)
#pragma unroll
            for (int m = 0; m < 4; ++m) { bf16_t* op = U + (size_t)(row0 + ai * HALF + m * 16) * UP + col0;
#pragma unroll
                for (int bj = 0; bj < 2; ++bj) { const u32x4 b = gb[ai][m][bj]; const f32x4 v0 = acc[ai][bj][m][0], v1 = acc[ai][bj][m][1];
                    u32x4 w; w.x = cvt_pk_bf16(v0[0] * bf_lo(b.x), v0[1] * bf_hi(b.x)); w.y = cvt_pk_bf16(v0[2] * bf_lo(b.y), v0[3] * bf_hi(b.y));
                    w.z = cvt_pk_bf16(v1[0] * bf_lo(b.z), v1[1] * bf_hi(b.z)); w.w = cvt_pk_bf16(v1[2] * bf_lo(b.w), v1[3] * bf_hi(b.w));
                    *(u32x4*)(op + bj * HALF) = w; } }
    }
};
struct EpiWo {
    static constexpr bool PERM = false, AFTER_DRAIN = false, HAS_MID = false;
    const float* x; const float* mod; float* out; float* rowsq;
    __device__ __forceinline__ void operator()(const f32x4 (&acc)[2][2][4][2], const Unit& u, int wr, int wc, int fr, int fq) const {
        const int b = u.pm >> 5; const float* ga1 = mod + (size_t)b * 12288 + 4096;
        int row0 = u.pm * BM + wr * 64 + fr, col0 = u.pn * BM + wc * 32 + 4 * fq; asm volatile("" : "+v"(row0), "+v"(col0));
        f32x4 gv[2][2];
#pragma unroll
        for (int bj = 0; bj < 2; ++bj)
#pragma unroll
            for (int n = 0; n < 2; ++n) gv[bj][n] = *(const f32x4*)(ga1 + col0 + bj * HALF + n * 16);
#pragma unroll
        for (int ai = 0; ai < 2; ++ai) { f32x4 xv[4][2][2];
#pragma unroll
            for (int m = 0; m < 4; ++m) { const size_t off = (size_t)(row0 + ai * HALF + m * 16) * DM + col0;
#pragma unroll
                for (int bj = 0; bj < 2; ++bj)
#pragma unroll
                    for (int n = 0; n < 2; ++n) xv[m][bj][n] = *(const f32x4*)(x + off + bj * HALF + n * 16); }
#pragma unroll
            for (int m = 0; m < 4; ++m) { const int row = row0 + ai * HALF + m * 16; const size_t off = (size_t)row * DM + col0; float ss = 0.f;
#pragma unroll
                for (int bj = 0; bj < 2; ++bj)
#pragma unroll
                    for (int n = 0; n < 2; ++n) { const f32x4 o = xv[m][bj][n] + gv[bj][n] * acc[ai][bj][m][n];
                        *(f32x4*)(out + off + bj * HALF + n * 16) = o; ss += (o[0] * o[0] + o[1] * o[1]) + (o[2] * o[2] + o[3] * o[3]); }
                ss += __shfl_xor(ss, 16); ss += __shfl_xor(ss, 32);
                if (fq == 0) rowsq[(size_t)row * 32 + u.pn * 4 + wc] = ss; }
            asm volatile("" ::: "memory"); }
    }
};
struct EpiWoDrain {
    static constexpr bool PERM = false, AFTER_DRAIN = true, HAS_MID = false;
    const float* x; const float* mod; float* out; float* rowsq;
    __device__ __forceinline__ void fused(f32x4 (&acc)[2][2][4][2], const Unit& u, int, int, int, int, PG8_LAS unsigned char* lds, int, int) const {
        int t2 = threadIdx.x; asm volatile("" : "+v"(t2));
        const int lane = t2 & 63, fr = lane & 15, fq = lane >> 4, wid = __builtin_amdgcn_readfirstlane(t2 >> 6), wr = wid >> 2, wc = wid & 3;
        const int b = u.pm >> 5; const float* ga1 = mod + (size_t)b * 12288 + 4096;
        const int colg = u.pn * BM;
        constexpr int TS = 1040;
#define EWD_BAR() do { asm volatile("s_waitcnt lgkmcnt(0)" ::: "memory"); __builtin_amdgcn_s_barrier(); asm volatile("" ::: "memory"); } while (0)
#pragma unroll
        for (int ai = 0; ai < 2; ++ai)
#pragma unroll
            for (int wq = 0; wq < 2; ++wq) { const int rbase = u.pm * BM + ai * HALF + wq * 64;
#pragma unroll
                for (int i4 = 0; i4 < 8; i4 += 4) { f32x4 xin[4];
#pragma unroll
                    for (int i = 0; i < 4; ++i) xin[i] = *(const f32x4*)(x + (size_t)(rbase + 8 * wid + i4 + i) * DM + colg + 4 * lane);
#pragma unroll
                    for (int i = 0; i < 4; ++i) *(PG8_LAS f32x4*)(lds + (8 * wid + i4 + i) * TS + lane * 16) = xin[i]; }
                EWD_BAR();
                if (wr == wq) {
                    f32x4 gv[2][2];
#pragma unroll
                    for (int bj = 0; bj < 2; ++bj)
#pragma unroll
                        for (int n = 0; n < 2; ++n) gv[bj][n] = *(const f32x4*)(ga1 + colg + bj * HALF + wc * 32 + n * 16 + 4 * fq);
#pragma unroll
                    for (int m = 0; m < 4; ++m) { const int rq = 16 * m + fr; float ss = 0.f;
#pragma unroll
                        for (int bj = 0; bj < 2; ++bj)
#pragma unroll
                            for (int n = 0; n < 2; ++n) { PG8_LAS f32x4* p = (PG8_LAS f32x4*)(lds + rq * TS + (bj * HALF + wc * 32 + n * 16 + 4 * fq) * 4);
                                const f32x4 o = *p + gv[bj][n] * acc[ai][bj][m][n]; *p = o; ss += (o[0] * o[0] + o[1] * o[1]) + (o[2] * o[2] + o[3] * o[3]); }
                        ss += __shfl_xor(ss, 16); ss += __shfl_xor(ss, 32);
                        if (fq == 0) rowsq[(size_t)(rbase + rq) * 32 + u.pn * 4 + wc] = ss; }
                }
                EWD_BAR();
#pragma unroll
                for (int i = 0; i < 8; ++i) { const f32x4 v = *(const PG8_LAS f32x4*)(lds + (8 * wid + i) * TS + lane * 16); *(f32x4*)(out + (size_t)(rbase + 8 * wid + i) * DM + colg + 4 * lane) = v; }
                EWD_BAR(); }
#undef EWD_BAR
    }
};
struct EpiSwiglu {
    static constexpr bool PERM = true, AFTER_DRAIN = false, HAS_MID = false;
    bf16_t* act;
    __device__ __forceinline__ void operator()(const f32x4 (&acc)[2][2][4][2], const Unit& u, int wr, int wc, int fr, int fq) const {
        const int row0 = u.pm * BM + wr * 64 + fr, col0 = u.pn * HALF + wc * 32 + 8 * fq;
#pragma unroll
        for (int ai = 0; ai < 2; ++ai)
#pragma unroll
            for (int m = 0; m < 4; ++m) { bf16_t* op = act + (size_t)(row0 + ai * HALF + m * 16) * FF + col0; float v[8];
#pragma unroll
                for (int n = 0; n < 2; ++n)
#pragma unroll
                    for (int e = 0; e < 4; ++e) { const float a = acc[ai][0][m][n][e], uu = acc[ai][1][m][n][e]; v[n * 4 + e] = a * sigmoidf_(a) * uu; }
                u32x4 w; w.x = cvt_pk_bf16(v[0], v[1]); w.y = cvt_pk_bf16(v[2], v[3]); w.z = cvt_pk_bf16(v[4], v[5]); w.w = cvt_pk_bf16(v[6], v[7]);
                *(u32x4*)op = w; }
    }
};
struct EpiDown {
    static constexpr bool PERM = true, AFTER_DRAIN = false, HAS_MID = false;
    const float* gsel; const float* mod; bf16_t* ym;
    __device__ __forceinline__ void operator()(const f32x4 (&acc)[2][2][4][2], const Unit& u, int wr, int wc, int fr, int fq) const {
        const int b = u.pm >> 6; const float* ga2 = mod + (size_t)b * 12288 + 10240;
        const int row0 = u.pm * BM + wr * 64 + fr, col0 = u.pn * BM + wc * 32 + 8 * fq;
        f32x4 gv[2][2];
#pragma unroll
        for (int bj = 0; bj < 2; ++bj)
#pragma unroll
            for (int n = 0; n < 2; ++n) gv[bj][n] = *(const f32x4*)(ga2 + col0 + bj * HALF + n * 4);
#pragma unroll
        for (int ai = 0; ai < 2; ++ai)
#pragma unroll
            for (int m = 0; m < 4; ++m) { const int row = row0 + ai * HALF + m * 16; const float gs = gsel[row]; bf16_t* op = ym + (size_t)row * DM + col0;
#pragma unroll
                for (int bj = 0; bj < 2; ++bj) { const f32x4 v0 = acc[ai][bj][m][0] * gv[bj][0] * gs, v1 = acc[ai][bj][m][1] * gv[bj][1] * gs;
                    u32x4 w; w.x = cvt_pk_bf16(v0[0], v0[1]); w.y = cvt_pk_bf16(v0[2], v0[3]); w.z = cvt_pk_bf16(v1[0], v1[1]); w.w = cvt_pk_bf16(v1[2], v1[3]);
                    *(u32x4*)(op + bj * HALF) = w; } }
    }
};

template <class Epi, class Sched, bool ALIGN_EPI = false, bool SP2 = false>
__device__ __forceinline__ void gemm_phase(PG8_LAS unsigned char* lds, const Gemm g, const Sched& S, const Epi& E) {
    const int tid = threadIdx.x, wid = __builtin_amdgcn_readfirstlane(tid >> 6), lane = tid & 63, wr = wid >> 2, wc = wid & 3, fr = lane & 15, fq = lane >> 4;
    const int K = g.K, nt = K / BK, lda = g.lda ? g.lda : K;
    unsigned voffA[2], voffB[2];
#pragma unroll
    for (int i = 0; i < 2; ++i) { int R, C; stage_rc(tid * 16 + i * 8192, R, C); const int Rb = Epi::PERM ? ((R & ~31) + perm32(R & 31)) : R;
        voffA[i] = (unsigned)(R * lda + C) * 2u; voffB[i] = (unsigned)(tid * 16 + i * 8192); (void)Rb; }
    unsigned gc0[2] = {0u, 0u}, gc1[2] = {0u, 0u}, gn0[2] = {0u, 0u}, gn1[2] = {0u, 0u};
#define PG8_GLOOK(u, o0, o1) do { _Pragma("unroll") for (int _i = 0; _i < 2; ++_i) { int R_, C_; stage_rc(tid * 16 + _i * 8192, R_, C_); \
        o0[_i] = (unsigned)S.rowmap[(u).pm * BM + R_] * (unsigned)(K * 2) + (unsigned)(C_ * 2); o1[_i] = (unsigned)S.rowmap[(u).pm * BM + HALF + R_] * (unsigned)(K * 2) + (unsigned)(C_ * 2); } } while (0)
    const size_t kstep = (size_t)(BK * 2);
    const size_t hstep = (size_t)HALF * lda * 2;
    const size_t tstep = 2 * hstep;
    const size_t kstepB = 32768, hstepB = 16384, tstepB = (size_t)nt * 32768;
    const unsigned ldsw = (unsigned)wid * 1024u;
    const int aoff = lds_byte(wr * 64 + fr, fq * 8), boff = lds_byte(wc * 32 + fr, fq * 8);
#define PG8_SA(b, h) (((b) * 2 + (h)) * HTB)
#define PG8_SB(b, h) ((4 + (b) * 2 + (h)) * HTB)
#define PG8_STAGE(bufoff, gbase, voff) do { _Pragma("unroll") for (int _i = 0; _i < 2; ++_i) \
        __builtin_amdgcn_global_load_lds((const unsigned*)((const char*)(gbase) + (voff)[_i]), (PG8_LAS unsigned*)(lds + (bufoff) + ldsw + _i * 8192), 16, 0, 0); } while (0)
#define PG8_STAGE_AC(bufoff, kptr, half) do { if constexpr (Sched::GATHER) { if constexpr ((half) == 0) PG8_STAGE(bufoff, kptr, gc0); else PG8_STAGE(bufoff, kptr, gc1); } else { PG8_STAGE(bufoff, (kptr) + (half) * hstep, voffA); } } while (0)
#define PG8_STAGE_AS(bufoff, kptr, half) do { if constexpr (Sched::GATHER) { if constexpr ((half) == 0) PG8_STAGE(bufoff, kptr, gs0); else PG8_STAGE(bufoff, kptr, gs1); } else { PG8_STAGE(bufoff, (kptr) + (half) * hstep, voffA); } } while (0)
#define PG8_LDA(dst, b, h) do { _Pragma("unroll") for (int m = 0; m < 4; ++m) _Pragma("unroll") for (int k = 0; k < 2; ++k) dst[m][k] = *(const PG8_LAS bf16x8*)(lds + PG8_SA(b, h) + aoff + m * 2048 + k * 1024); } while (0)
#define PG8_LDB(dst, b, h) do { _Pragma("unroll") for (int n = 0; n < 2; ++n) _Pragma("unroll") for (int k = 0; k < 2; ++k) dst[n][k] = *(const PG8_LAS bf16x8*)(lds + PG8_SB(b, h) + boff + n * 2048 + k * 1024); } while (0)
#define PG8_MMA(ai, bj, At, Bt) do { __builtin_amdgcn_s_setprio(1); _Pragma("unroll") for (int m = 0; m < 4; ++m) _Pragma("unroll") for (int n = 0; n < 2; ++n) _Pragma("unroll") for (int k = 0; k < 2; ++k) \
        acc[ai][bj][m][n] = __builtin_amdgcn_mfma_f32_16x16x32_bf16(Bt[n][k], At[m][k], acc[ai][bj][m][n], 0, 0, 0); __builtin_amdgcn_s_setprio(0); } while (0)
#define PG8_WAIT_V(n) asm volatile("s_waitcnt vmcnt(" #n ")" ::: "memory")
#define PG8_WAIT_L(n) asm volatile("s_waitcnt lgkmcnt(" #n ")" ::: "memory")
#define PG8_BAR __builtin_amdgcn_s_barrier()
#define PG8_SCHED __builtin_amdgcn_sched_barrier(0)
    Unit cur, nxt; int ui = 0;
    if (!S.next(0, cur)) return;
    f32x4 acc[2][2][4][2];
#pragma unroll
    for (int a = 0; a < 2; ++a)
#pragma unroll
        for (int b = 0; b < 2; ++b)
#pragma unroll
            for (int m = 0; m < 4; ++m)
#pragma unroll
                for (int n = 0; n < 2; ++n) acc[a][b][m][n] = (f32x4){0.f, 0.f, 0.f, 0.f};
    bf16x8 At[4][2], B0[2][2], B1[2][2];
    const char* cA = (const char*)g.A + (Sched::GATHER ? (size_t)0 : (size_t)cur.pm * tstep); const char* cB = (const char*)g.Bt + S.bofs(cur) + (size_t)cur.pn * tstepB;
    if constexpr (Sched::GATHER) { static_assert(!Sched::GATHER || SP2, "GATHER is wired into the SP2 loop only"); PG8_GLOOK(cur, gc0, gc1); }
    S.a_ready(cur);
    if constexpr (SP2) {
        PG8_STAGE(PG8_SB(0, 0), cB, voffB); PG8_STAGE(PG8_SB(0, 1), cB + hstepB, voffB); PG8_STAGE_AC(PG8_SA(0, 0), cA, 0); PG8_STAGE_AC(PG8_SA(0, 1), cA, 1);
        if (wr == 1) PG8_BAR;
        PG8_WAIT_V(2); PG8_BAR;
        PG8_STAGE(PG8_SB(1, 0), cB + kstepB, voffB); PG8_STAGE_AC(PG8_SA(1, 0), cA + kstep, 0); PG8_STAGE(PG8_SB(1, 1), cB + hstepB + kstepB, voffB);
        PG8_WAIT_V(6); PG8_BAR;
    } else {
        PG8_STAGE(PG8_SB(0, 0), cB, voffB); PG8_STAGE(PG8_SA(0, 0), cA, voffA); PG8_STAGE(PG8_SB(0, 1), cB + hstepB, voffB); PG8_STAGE(PG8_SA(0, 1), cA + hstep, voffA);
        if (wr == 1) PG8_BAR;
        PG8_WAIT_V(4); PG8_BAR;
        PG8_STAGE(PG8_SB(1, 0), cB + kstepB, voffB); PG8_STAGE(PG8_SA(1, 0), cA + kstep, voffA); PG8_STAGE(PG8_SB(1, 1), cB + hstepB + kstepB, voffB);
        PG8_WAIT_V(6); PG8_BAR;
    }
    for (;;) {
        const bool has_next = S.next(ui + 1, nxt);
        const char* nA = (has_next && !Sched::GATHER) ? (const char*)g.A + (size_t)nxt.pm * tstep : cA;
        if constexpr (Sched::GATHER) { if (has_next) PG8_GLOOK(nxt, gn0, gn1); else { gn0[0] = gc0[0]; gn0[1] = gc0[1]; gn1[0] = gc1[0]; gn1[1] = gc1[1]; } } const char* nB = has_next ? (const char*)g.Bt + S.bofs(nxt) + (size_t)nxt.pn * tstepB : cB;
        for (int t = 0; t < nt; t += 2) {
            const bool last = (t == nt - 2);
            if constexpr (Epi::HAS_MID) { if (t == (nt >> 1)) E.mid(acc, cur, wr, wc, fr, fq); }
            const char* a1 = cA + (size_t)(t + 1) * kstep;
            const char* a2 = last ? nA : cA + (size_t)(t + 2) * kstep; const char* b2 = last ? nB : cB + (size_t)(t + 2) * kstepB;
            const char* a3 = a2 + kstep; const char* b3 = b2 + kstepB;
            unsigned gs0[2], gs1[2]; if constexpr (Sched::GATHER) { gs0[0] = last ? gn0[0] : gc0[0]; gs0[1] = last ? gn0[1] : gc0[1]; gs1[0] = last ? gn1[0] : gc1[0]; gs1[1] = last ? gn1[1] : gc1[1]; } else { gs0[0] = gs0[1] = gs1[0] = gs1[1] = 0u; }
            if (last && has_next) S.a_ready(nxt);
            if constexpr (SP2) {
            PG8_LDB(B0, 0, 0); PG8_LDB(B1, 0, 1); PG8_SCHED; PG8_LDA(At, 0, 0); PG8_STAGE_AC(PG8_SA(1, 1), a1, 1);
            PG8_WAIT_V(8); PG8_WAIT_L(0); PG8_BAR; PG8_MMA(0, 0, At, B0); PG8_MMA(0, 1, At, B1); PG8_BAR; PG8_SCHED;
            PG8_LDA(At, 0, 1); PG8_STAGE(PG8_SB(0, 0), b2, voffB); PG8_STAGE(PG8_SB(0, 1), b2 + hstepB, voffB); PG8_STAGE_AS(PG8_SA(0, 0), a2, 0);
            PG8_WAIT_V(8); PG8_WAIT_L(0); PG8_BAR; PG8_MMA(1, 0, At, B0); PG8_MMA(1, 1, At, B1); PG8_BAR; PG8_SCHED;
            PG8_LDB(B0, 1, 0); PG8_LDB(B1, 1, 1); PG8_SCHED; PG8_LDA(At, 1, 0); PG8_STAGE_AS(PG8_SA(0, 1), a2, 1);
            PG8_WAIT_V(8); PG8_WAIT_L(0); PG8_BAR; PG8_MMA(0, 0, At, B0); PG8_MMA(0, 1, At, B1); PG8_BAR; PG8_SCHED;
            PG8_LDA(At, 1, 1); PG8_STAGE(PG8_SB(1, 0), b3, voffB); PG8_STAGE(PG8_SB(1, 1), b3 + hstepB, voffB); PG8_STAGE_AS(PG8_SA(1, 0), a3, 0);
            PG8_WAIT_V(8); PG8_WAIT_L(0); PG8_BAR; PG8_MMA(1, 0, At, B0); PG8_MMA(1, 1, At, B1); PG8_BAR; PG8_SCHED;
            } else {
            PG8_LDB(B0, 0, 0); PG8_SCHED; PG8_LDA(At, 0, 0); PG8_STAGE(PG8_SA(1, 1), a1 + hstep, voffA);
            PG8_WAIT_L(8); PG8_BAR; PG8_WAIT_L(0); PG8_MMA(0, 0, At, B0); PG8_BAR; PG8_SCHED;
            PG8_LDB(B1, 0, 1); PG8_STAGE(PG8_SB(0, 0), b2, voffB);
            PG8_BAR; PG8_WAIT_L(0); PG8_MMA(0, 1, At, B1); PG8_BAR;
            PG8_LDA(At, 0, 1); PG8_STAGE(PG8_SA(0, 0), a2, voffA);
            PG8_BAR; PG8_WAIT_L(0); PG8_MMA(1, 0, At, B0); PG8_BAR; PG8_SCHED;
            PG8_STAGE(PG8_SB(0, 1), b2 + hstepB, voffB);
            PG8_WAIT_V(6); PG8_BAR; PG8_MMA(1, 1, At, B1); PG8_BAR;
            PG8_LDB(B0, 1, 0); PG8_SCHED; PG8_LDA(At, 1, 0); PG8_STAGE(PG8_SA(0, 1), a2 + hstep, voffA);
            PG8_WAIT_L(8); PG8_BAR; PG8_WAIT_L(0); PG8_MMA(0, 0, At, B0); PG8_BAR; PG8_SCHED;
            PG8_LDB(B1, 1, 1); PG8_STAGE(PG8_SB(1, 0), b3, voffB);
            PG8_BAR; PG8_WAIT_L(0); PG8_MMA(0, 1, At, B1); PG8_BAR;
            PG8_LDA(At, 1, 1); PG8_STAGE(PG8_SA(1, 0), a3, voffA);
            PG8_BAR; PG8_WAIT_L(0); PG8_MMA(1, 0, At, B0); PG8_BAR; PG8_SCHED;
            PG8_STAGE(PG8_SB(1, 1), b3 + hstepB, voffB);
            PG8_WAIT_V(6); PG8_BAR; PG8_MMA(1, 1, At, B1); PG8_BAR;
            }
        }
        if constexpr (ALIGN_EPI) { if (wr == 0) PG8_BAR; }
        if constexpr (!Epi::AFTER_DRAIN) { E(acc, cur, wr, wc, fr, fq); S.done(cur); }
        if (!has_next) break;
#pragma unroll
        for (int a = 0; a < 2; ++a)
#pragma unroll
            for (int b = 0; b < 2; ++b)
#pragma unroll
                for (int m = 0; m < 4; ++m)
#pragma unroll
                    for (int n = 0; n < 2; ++n) acc[a][b][m][n] = (f32x4){0.f, 0.f, 0.f, 0.f};
        cur = nxt; cA = nA; cB = nB; ++ui;
        if constexpr (Sched::GATHER) { gc0[0] = gn0[0]; gc0[1] = gn0[1]; gc1[0] = gn1[0]; gc1[1] = gn1[1]; }
        if constexpr (ALIGN_EPI) { if (wr == 1) PG8_BAR; }
    }
    PG8_WAIT_V(0);
    if constexpr (!ALIGN_EPI) { if (wr == 0) PG8_BAR; }
    PG8_BAR;
    if constexpr (Epi::AFTER_DRAIN) { E.fused(acc, cur, wr, wc, fr, fq, lds, wid, lane); S.done(cur); }
#undef PG8_SA
#undef PG8_SB
#undef PG8_STAGE
#undef PG8_STAGE_AC
#undef PG8_STAGE_AS
#undef PG8_GLOOK
#undef PG8_LDA
#undef PG8_LDB
#undef PG8_MMA
#undef PG8_WAIT_V
#undef PG8_WAIT_L
#undef PG8_BAR
#undef PG8_SCHED
}
}

namespace att {
using bf16x8 = __attribute__((ext_vector_type(8))) short;
using s16x4  = __attribute__((ext_vector_type(4))) short;
using f32x16 = __attribute__((ext_vector_type(16))) float;
using u32x4  = __attribute__((ext_vector_type(4))) unsigned;
typedef unsigned short bf16_t;
constexpr int LDR = 1024;
constexpr int SHM_V = 64 * 128 * 2, SHM_K = 64 * 128 * 2;
constexpr int SLOT = SHM_V + SHM_K, NSLOT = 4;
constexpr int LDS_WS = 131072 + 1024;
constexpr int LDS_BIAS = LDS_WS + 8 * 64 * 4;
constexpr int LDS_ATT_BYTES = LDS_BIAS + 2048;
#define KSWZ(row, colB) ((row) * 256 + ((colB) ^ (((row) & 15) << 4)))
#define SBAR() __builtin_amdgcn_sched_barrier(0)
__device__ __forceinline__ int crow(int r, int hi) { return (r & 3) + 8 * (r >> 2) + 4 * hi; }
typedef float f32x2_cv __attribute__((ext_vector_type(2))); typedef __bf16 bf16x2_cv __attribute__((ext_vector_type(2)));
__device__ __forceinline__ unsigned cvtpk(float lo, float hi) { const f32x2_cv v = {lo, hi}; const bf16x2_cv b = __builtin_convertvector(v, bf16x2_cv); return __builtin_bit_cast(unsigned, b); }
__device__ __forceinline__ int v_st(int k, int c) { const int kk = (k & ~0xC) | ((k & 4) << 1) | ((k & 8) >> 1); return ((kk >> 3) * 4 + (c >> 5)) * 512 + ((kk & 7) * 32 + (c & 31)) * 2; }
__device__ __forceinline__ int v_rd_base(int lane) { return ((lane & 3) << 3) | (((lane >> 2) & 3) << 6) | (((lane >> 4) & 1) << 5) | (((lane >> 5) & 1) << 8); }
constexpr int v_rd_off(int d0, int ks, int half) { return d0 * 512 + ks * 4096 + half * 2048; }
template <int OFF> __device__ __forceinline__ s16x4 tr_read(int vb) { s16x4 r; asm volatile("ds_read_b64_tr_b16 %0, %1 offset:%2" : "=&v"(r) : "v"(vb), "i"(OFF) : "memory"); return r; }
template <int D0> __device__ __forceinline__ void pv_one(f32x16& od, int vb, bf16x8 pa0, bf16x8 pa1, bf16x8 pa2, bf16x8 pa3) {
    const s16x4 l0 = tr_read<v_rd_off(D0, 0, 0)>(vb), h0 = tr_read<v_rd_off(D0, 0, 1)>(vb), l1 = tr_read<v_rd_off(D0, 1, 0)>(vb), h1 = tr_read<v_rd_off(D0, 1, 1)>(vb);
    const s16x4 l2 = tr_read<v_rd_off(D0, 2, 0)>(vb), h2 = tr_read<v_rd_off(D0, 2, 1)>(vb), l3 = tr_read<v_rd_off(D0, 3, 0)>(vb), h3 = tr_read<v_rd_off(D0, 3, 1)>(vb);
    asm volatile("s_waitcnt lgkmcnt(0)" ::: "memory"); SBAR();
#define PK(L, H) (bf16x8){L[0], L[1], L[2], L[3], H[0], H[1], H[2], H[3]}
    od = __builtin_amdgcn_mfma_f32_32x32x16_bf16(pa0, PK(l0, h0), od, 0, 0, 0);
    od = __builtin_amdgcn_mfma_f32_32x32x16_bf16(pa1, PK(l1, h1), od, 0, 0, 0);
    od = __builtin_amdgcn_mfma_f32_32x32x16_bf16(pa2, PK(l2, h2), od, 0, 0, 0);
    od = __builtin_amdgcn_mfma_f32_32x32x16_bf16(pa3, PK(l3, h3), od, 0, 0, 0);
#undef PK
}
__device__ __forceinline__ void pv_d0(f32x16* o, int vb, bf16x8 pa0, bf16x8 pa1, bf16x8 pa2, bf16x8 pa3) {
    pv_one<0>(o[0], vb, pa0, pa1, pa2, pa3); pv_one<1>(o[1], vb, pa0, pa1, pa2, pa3); pv_one<2>(o[2], vb, pa0, pa1, pa2, pa3); pv_one<3>(o[3], vb, pa0, pa1, pa2, pa3);
}
template <int D0, int KB> __device__ __forceinline__ void pvb_one(f32x16& od, int vb, bf16x8 pa, bf16x8 pb) {
    const s16x4 l0 = tr_read<v_rd_off(D0, 2 * KB, 0)>(vb), h0 = tr_read<v_rd_off(D0, 2 * KB, 1)>(vb), l1 = tr_read<v_rd_off(D0, 2 * KB + 1, 0)>(vb), h1 = tr_read<v_rd_off(D0, 2 * KB + 1, 1)>(vb);
    asm volatile("s_waitcnt lgkmcnt(0)" ::: "memory"); SBAR();
#define PK(L, H) (bf16x8){L[0], L[1], L[2], L[3], H[0], H[1], H[2], H[3]}
    od = __builtin_amdgcn_mfma_f32_32x32x16_bf16(pa, PK(l0, h0), od, 0, 0, 0);
    od = __builtin_amdgcn_mfma_f32_32x32x16_bf16(pb, PK(l1, h1), od, 0, 0, 0);
#undef PK
}
template <int D0, int ND> __device__ __forceinline__ void qkt(f32x16& p0, f32x16& p1, const char* Ks, const bf16x8* qr, int r32, int hi) {
    p0 = f32x16{}; p1 = f32x16{};
#pragma unroll
    for (int d0 = D0; d0 < D0 + ND; ++d0) { const int cb = (d0 * 16 + hi * 8) * 2;
        const bf16x8 b0 = *reinterpret_cast<const bf16x8*>(Ks + KSWZ(r32, cb));
        const bf16x8 b1 = *reinterpret_cast<const bf16x8*>(Ks + KSWZ(32 + r32, cb));
        p0 = __builtin_amdgcn_mfma_f32_32x32x16_bf16(b0, qr[d0], p0, 0, 0, 0);
        p1 = __builtin_amdgcn_mfma_f32_32x32x16_bf16(b1, qr[d0], p1, 0, 0, 0); }
}
__device__ __forceinline__ void pack_p(const f32x16& p0, const f32x16& p1, bf16x8& pa0, bf16x8& pa1, bf16x8& pa2, bf16x8& pa3) {
#define PK4(P, BASE, OUT) do { unsigned a0 = cvtpk(P[BASE + 0], P[BASE + 1]), a1 = cvtpk(P[BASE + 2], P[BASE + 3]);   \
    unsigned b0 = cvtpk(P[BASE + 4], P[BASE + 5]), b1 = cvtpk(P[BASE + 6], P[BASE + 7]);                              \
    auto r0 = __builtin_amdgcn_permlane32_swap(a0, b0, false, false); auto r1 = __builtin_amdgcn_permlane32_swap(a1, b1, false, false); \
    u32x4 w = {r0[0], r1[0], r0[1], r1[1]}; OUT = *reinterpret_cast<bf16x8*>(&w); } while (0)
    PK4(p0, 0, pa0); PK4(p0, 8, pa1); PK4(p1, 0, pa2); PK4(p1, 8, pa3);
#undef PK4
}
template <int BASE> __device__ __forceinline__ bf16x8 pk4f(const f32x16& P) {
    const unsigned a0 = cvtpk(P[BASE + 0], P[BASE + 1]), a1 = cvtpk(P[BASE + 2], P[BASE + 3]), b0 = cvtpk(P[BASE + 4], P[BASE + 5]), b1 = cvtpk(P[BASE + 6], P[BASE + 7]);
    const auto r0 = __builtin_amdgcn_permlane32_swap(a0, b0, false, false); const auto r1 = __builtin_amdgcn_permlane32_swap(a1, b1, false, false);
    u32x4 w = {r0[0], r1[0], r0[1], r1[1]}; return *reinterpret_cast<bf16x8*>(&w);
}
template <int D0, int KS> __device__ __forceinline__ void pv_one1(f32x16& od, int vb, bf16x8 pA) {
    const s16x4 l0 = tr_read<v_rd_off(D0, KS, 0)>(vb), h0 = tr_read<v_rd_off(D0, KS, 1)>(vb);
    asm volatile("s_waitcnt lgkmcnt(0)" ::: "memory"); SBAR();
    od = __builtin_amdgcn_mfma_f32_32x32x16_bf16(pA, (bf16x8){l0[0], l0[1], l0[2], l0[3], h0[0], h0[1], h0[2], h0[3]}, od, 0, 0, 0);
}
template <int D0, int KS0> __device__ __forceinline__ void pv_one3(f32x16& od, int vb, bf16x8 pA, bf16x8 pB, bf16x8 pC) {
    const s16x4 l0 = tr_read<v_rd_off(D0, KS0, 0)>(vb), h0 = tr_read<v_rd_off(D0, KS0, 1)>(vb), l1 = tr_read<v_rd_off(D0, KS0 + 1, 0)>(vb), h1 = tr_read<v_rd_off(D0, KS0 + 1, 1)>(vb);
    const s16x4 l2 = tr_read<v_rd_off(D0, KS0 + 2, 0)>(vb), h2 = tr_read<v_rd_off(D0, KS0 + 2, 1)>(vb);
    asm volatile("s_waitcnt lgkmcnt(0)" ::: "memory"); SBAR();
#define PK(L, H) (bf16x8){L[0], L[1], L[2], L[3], H[0], H[1], H[2], H[3]}
    od = __builtin_amdgcn_mfma_f32_32x32x16_bf16(pA, PK(l0, h0), od, 0, 0, 0);
    od = __builtin_amdgcn_mfma_f32_32x32x16_bf16(pB, PK(l1, h1), od, 0, 0, 0);
    od = __builtin_amdgcn_mfma_f32_32x32x16_bf16(pC, PK(l2, h2), od, 0, 0, 0);
#undef PK
}
__device__ __forceinline__ float half_sum(float v) { auto rr = __builtin_amdgcn_permlane32_swap(__float_as_uint(v), __float_as_uint(v), false, false); return __uint_as_float(rr[0]) + __uint_as_float(rr[1]); }

struct Stager {
    int sr, sc, vst0, vst1; bf16x8 vs0, vs1, ks0, ks1;
    __device__ __forceinline__ void init(int tid) { sr = tid >> 4; sc = (tid & 15) * 8; vst0 = v_st(sr, sc); vst1 = v_st(32 + sr, sc); }
    __device__ __forceinline__ void load(const bf16_t* Kt, const bf16_t* Vt) {
        vs0 = *reinterpret_cast<const bf16x8*>(Vt + (size_t)sr * LDR + sc); vs1 = *reinterpret_cast<const bf16x8*>(Vt + (size_t)(32 + sr) * LDR + sc);
        ks0 = *reinterpret_cast<const bf16x8*>(Kt + (size_t)sr * LDR + sc); ks1 = *reinterpret_cast<const bf16x8*>(Kt + (size_t)(32 + sr) * LDR + sc);
    }
    __device__ __forceinline__ void write(char* lds, int b) {
        *(bf16x8*)(lds + b * SHM_V + vst0) = vs0; *(bf16x8*)(lds + b * SHM_V + vst1) = vs1; const int kc = sc * 2;
        *(bf16x8*)(lds + 2 * SHM_V + b * SHM_K + KSWZ(sr, kc)) = ks0; *(bf16x8*)(lds + 2 * SHM_V + b * SHM_K + KSWZ(32 + sr, kc)) = ks1;
    }
};

typedef float f32x4v __attribute__((ext_vector_type(4)));
#define MFMA16(a, b, c) __builtin_amdgcn_mfma_f32_16x16x32_bf16(a, b, c, 0, 0, 0)
template <int DT, int KB> __device__ __forceinline__ void pvb16_pair(f32x4v (&o)[2][8], int vb, bf16x8 pa, bf16x8 pb) {
    const s16x4 l0 = tr_read<((2 * KB) * 8 + DT) * 512>(vb), h0 = tr_read<((2 * KB + 1) * 8 + DT) * 512>(vb), l1 = tr_read<((2 * KB) * 8 + DT + 1) * 512>(vb), h1 = tr_read<((2 * KB + 1) * 8 + DT + 1) * 512>(vb);
    asm volatile("s_waitcnt lgkmcnt(0)" ::: "memory"); SBAR();
#define PK(L, H) (bf16x8){L[0], L[1], L[2], L[3], H[0], H[1], H[2], H[3]}
    o[0][DT] = MFMA16(pa, PK(l0, h0), o[0][DT]); o[1][DT] = MFMA16(pb, PK(l0, h0), o[1][DT]);
    o[0][DT + 1] = MFMA16(pa, PK(l1, h1), o[0][DT + 1]); o[1][DT + 1] = MFMA16(pb, PK(l1, h1), o[1][DT + 1]);
#undef PK
}
__device__ __forceinline__ void diff_epilogue(f32x4v (&o)[2][8], float l0, float l1, int b, int h, int qb, bf16_t* Y, float lam, const float* subln, char* lds);
__device__ __forceinline__ void diff_unit(int b, int h, int qb, const bf16_t* QA, const bf16_t* KA, const bf16_t* VA, bf16_t* Y, float lam, const float* subln, char* lds, __attribute__((address_space(3))) unsigned char* lds3) {
    int tid = threadIdx.x; asm volatile("" : "+v"(tid));
    const int lane = tid & 63, l15 = lane & 15, g = lane >> 4; const int wid = __builtin_amdgcn_readfirstlane(tid >> 6); const int br = wid >> 2, wq = wid & 3;
    const size_t qrow0 = (size_t)b * SEQ + (size_t)qb * 128 + wq * 32;
    const bf16_t* Kc = KA + ((size_t)MTOK + (size_t)b * CTXL) * LDR + h * 128; const bf16_t* Kl = KA + ((size_t)b * SEQ) * LDR + h * 128;
    const bf16_t* Vc = VA + ((size_t)MTOK + (size_t)b * CTXL) * LDR + h * 128; const bf16_t* Vl = VA + ((size_t)b * SEQ) * LDR + h * 128;
    constexpr int NT = (CTXL + SEQ) / 64;
    bf16x8 qr[2][2];
#pragma unroll
    for (int qt = 0; qt < 2; ++qt)
#pragma unroll
        for (int ds = 0; ds < 2; ++ds) qr[qt][ds] = *reinterpret_cast<const bf16x8*>(QA + (qrow0 + 16 * qt + l15) * LDR + h * 128 + br * 64 + 32 * ds + 8 * g);
    unsigned koff[2], voff[2];
#pragma unroll
    for (int i = 0; i < 2; ++i) { const int p = 2 * wid + i;
        const int krow = 4 * p + (lane >> 4), kch = (lane & 15) ^ (krow & 15); koff[i] = (unsigned)(krow * LDR + 8 * kch) * 2u;
        const int sub = 2 * p + (lane >> 5), key = (sub >> 3) * 16 + ((lane & 31) >> 1), col = (sub & 7) * 16 + 8 * (lane & 1);
        voff[i] = (unsigned)(key * LDR + col) * 2u; }
    const int vb0 = (int)(uintptr_t)lds + (4 * g + (l15 >> 2)) * 32 + (l15 & 3) * 8;
    const int kcb = br * 128 + g * 16;
    const unsigned pw = (unsigned)wid * 2048u;
#define TILE_K(t) ((const char*)((t) < 4 ? Kc + (size_t)(t) * 64 * LDR : Kl + (size_t)((t) - 4) * 64 * LDR))
#define TILE_V(t) ((const char*)((t) < 4 ? Vc + (size_t)(t) * 64 * LDR : Vl + (size_t)((t) - 4) * 64 * LDR))
#define DMA(t, so) do { const char* kt_ = TILE_K(t); const char* vt_ = TILE_V(t); \
    _Pragma("unroll") for (int i_ = 0; i_ < 2; ++i_) { \
        __builtin_amdgcn_global_load_lds((const unsigned*)(vt_ + voff[i_]), (__attribute__((address_space(3))) unsigned*)(lds3 + (so) + pw + i_ * 1024), 16, 0, 0); \
        __builtin_amdgcn_global_load_lds((const unsigned*)(kt_ + koff[i_]), (__attribute__((address_space(3))) unsigned*)(lds3 + (so) + SHM_V + pw + i_ * 1024), 16, 0, 0); } } while (0)
#define WAITBAR(n) asm volatile("s_waitcnt vmcnt(" #n ") lgkmcnt(0)\n\ts_barrier" ::: "memory")
#define QKB(P, so, kb) do { const char* Ks_ = lds + (so) + SHM_V; P[0] = f32x4v{}; P[1] = f32x4v{}; P[2] = f32x4v{}; P[3] = f32x4v{}; \
    _Pragma("unroll") for (int ds_ = 0; ds_ < 2; ++ds_) \
    _Pragma("unroll") for (int kt_ = 0; kt_ < 2; ++kt_) { \
        const bf16x8 a_ = *reinterpret_cast<const bf16x8*>(Ks_ + (32 * (kb) + 16 * kt_ + l15) * 256 + ((kcb + 64 * ds_) ^ (l15 << 4))); \
        P[kt_ * 2] = MFMA16(a_, qr[0][ds_], P[kt_ * 2]); P[kt_ * 2 + 1] = MFMA16(a_, qr[1][ds_], P[kt_ * 2 + 1]); } } while (0)
#define PKT(P, T0, T1, OUT) do { u32x4 w_ = {cvtpk(P[T0][0], P[T0][1]), cvtpk(P[T0][2], P[T0][3]), cvtpk(P[T1][0], P[T1][1]), cvtpk(P[T1][2], P[T1][3])}; OUT = *reinterpret_cast<bf16x8*>(&w_); } while (0)
#define FINB(P) do { float p0_ = 0.f, p1_ = 0.f; _Pragma("unroll") for (int e_ = 0; e_ < 4; ++e_) { \
        P[0][e_] = __builtin_amdgcn_exp2f(P[0][e_]); P[1][e_] = __builtin_amdgcn_exp2f(P[1][e_]); P[2][e_] = __builtin_amdgcn_exp2f(P[2][e_]); P[3][e_] = __builtin_amdgcn_exp2f(P[3][e_]); \
        p0_ += P[0][e_] + P[2][e_]; p1_ += P[1][e_] + P[3][e_]; } \
    l0 += p0_; l1 += p1_; PKT(P, 0, 2, paA); PKT(P, 1, 3, paB); } while (0)
#define PVB(so, kb) do { const int vb_ = vb0 + (so); pvb16_pair<0, kb>(o, vb_, paA, paB); pvb16_pair<2, kb>(o, vb_, paA, paB); pvb16_pair<4, kb>(o, vb_, paA, paB); pvb16_pair<6, kb>(o, vb_, paA, paB); } while (0)
#define ROT() do { s_prev = s_cur; s_cur = s_nxt; s_nxt = s_nx2; s_nx2 = (s_nx2 == (NSLOT - 1) * SLOT) ? 0 : s_nx2 + SLOT; } while (0)
    f32x4v o[2][8];
#pragma unroll
    for (int qt = 0; qt < 2; ++qt)
#pragma unroll
        for (int d = 0; d < 8; ++d) o[qt][d] = f32x4v{};
    float l0 = 0.f, l1 = 0.f; f32x4v pX[4], pY[4]; bf16x8 paA, paB;
    int s_prev = 0, s_cur = 0, s_nxt = SLOT, s_nx2 = 2 * SLOT;
    DMA(0, 0); DMA(1, SLOT);
    WAITBAR(4);
    DMA(2, 2 * SLOT);
    QKB(pX, 0, 0);
    SBAR(); QKB(pY, 0, 1); FINB(pX); SBAR();
    PVB(0, 0);
    WAITBAR(4);
    ROT();
#define STEP(j, HAS2) do { \
    if (HAS2) DMA((j) + 2, s_nx2); \
    SBAR(); QKB(pX, s_cur, 0); FINB(pY); SBAR(); \
    PVB(s_prev, 1); \
    SBAR(); QKB(pY, s_cur, 1); FINB(pX); SBAR(); \
    PVB(s_cur, 0); \
    if (HAS2) WAITBAR(4); else WAITBAR(0); \
    ROT(); } while (0)
    for (int j = 1; j + 2 < NT; ++j) STEP(j, true);
    STEP(NT - 2, false);
    STEP(NT - 1, false);
    FINB(pY); SBAR();
    PVB(s_prev, 1);
#undef QKB
#undef PKT
#undef FINB
#undef PVB
#undef TILE_K
#undef TILE_V
#undef DMA
#undef ROT
#undef STEP
#undef WAITBAR
    l0 += __shfl_xor(l0, 16); l0 += __shfl_xor(l0, 32); l1 += __shfl_xor(l1, 16); l1 += __shfl_xor(l1, 32);
    diff_epilogue(o, l0, l1, b, h, qb, Y, lam, subln, lds);
}
__device__ __forceinline__ void diff_epilogue(f32x4v (&o)[2][8], float l0, float l1, int b, int h, int qb, bf16_t* Y, float lam, const float* subln, char* lds) {
    int tid = threadIdx.x; asm volatile("" : "+v"(tid));
    const int lane = tid & 63, l15 = lane & 15, g = lane >> 4; const int wid = __builtin_amdgcn_readfirstlane(tid >> 6); const int br = wid >> 2, wq = wid & 3;
    float* ws = (float*)(lds + LDS_WS) + wid * 64;
    const size_t qrow0 = (size_t)b * SEQ + (size_t)qb * 128 + wq * 32;
#define WAITBAR(n) asm volatile("s_waitcnt vmcnt(" #n ") lgkmcnt(0)\n\ts_barrier" ::: "memory")
    if (g == 0) { ws[l15] = l0; ws[16 + l15] = l1; }
    WAITBAR(0);
    float* xb = (float*)lds + wq * 4096 + lane;
    if (br == 1) {
#pragma unroll
        for (int qt = 0; qt < 2; ++qt)
#pragma unroll
            for (int i = 0; i < 4; ++i) { const float i2 = lam * __builtin_amdgcn_rcpf(ws[16 * qt + 4 * g + i]);
#pragma unroll
                for (int d = 0; d < 8; ++d) xb[((qt * 8 + d) * 4 + i) * 64] = o[qt][d][i] * i2; }
    }
    WAITBAR(0);
    if (br == 0) {
        float sg[8];
#pragma unroll
        for (int d = 0; d < 8; ++d) sg[d] = subln[d * 16 + l15] * 0.8f;
#pragma unroll
        for (int qt = 0; qt < 2; ++qt)
#pragma unroll
            for (int i = 0; i < 4; ++i) { const int orow = 16 * qt + 4 * g + i; const float i1 = __builtin_amdgcn_rcpf(ws[orow]);
                float y[8], ss = 0.f;
#pragma unroll
                for (int d = 0; d < 8; ++d) { y[d] = o[qt][d][i] * i1 - xb[((qt * 8 + d) * 4 + i) * 64]; ss += y[d] * y[d]; }
                ss += __shfl_xor(ss, 1); ss += __shfl_xor(ss, 2); ss += __shfl_xor(ss, 4); ss += __shfl_xor(ss, 8);
                const float rs = __builtin_amdgcn_rsqf(ss * (1.0f / 128.0f) + EPS);
                bf16_t* yp = Y + (qrow0 + orow) * DM + h * 128 + l15;
#pragma unroll
                for (int d = 0; d < 8; ++d) { const unsigned w = cvtpk(y[d] * rs * sg[d], 0.f); yp[d * 16] = (bf16_t)(w & 0xffffu); } }
    }
    WAITBAR(0);
#undef WAITBAR
}

template <int H> __device__ __forceinline__ void na_unit_h(int b, int h, int rb, const bf16_t* QB, const bf16_t* KB, const bf16_t* VB, bf16_t* Y, const float* rpb, char* lds) {
    const int tid = threadIdx.x, lane = tid & 63, r32 = lane & 31, hi = lane >> 5; const int wid = __builtin_amdgcn_readfirstlane(tid >> 6);
    float* ws = (float*)(lds + LDS_WS) + wid * 64; float* bias = (float*)(lds + LDS_BIAS);
    if (tid < 15 * 31) bias[(tid / 31) * 128 + 48 + tid % 31] = rpb[h * 465 + tid] * LOG2E;
    const int R0 = rb * 4, rq = R0 + (wid >> 1), half = H, qc = half * 32 + r32;
    const int cs = min(max(qc - 8, 0), GRIDW - 16);
    const int rs0 = min(max(rq - 4, 0), GROWS - 8);
    const int krlo = min(max(R0 - 4, 0), GROWS - 8), krhi = min(max(R0 + 3 - 4, 0), GROWS - 8) + 7;
    int nlat = krhi - krlo + 1; const int NT = 4 + nlat;
    const size_t qrow0 = (size_t)b * SEQ + (size_t)R0 * 64 + wid * 32;
    bf16x8 qr[8];
    { const bf16_t* Qw = QB + (qrow0 + r32) * LDR + h * 128 + hi * 8;
#pragma unroll
      for (int d0 = 0; d0 < 8; ++d0) qr[d0] = *reinterpret_cast<const bf16x8*>(Qw + d0 * 16); }
    const bf16_t* Kc = KB + ((size_t)MTOK + (size_t)b * CTXL) * LDR + h * 128; const bf16_t* Kl = KB + ((size_t)b * SEQ + (size_t)krlo * 64) * LDR + h * 128;
    const bf16_t* Vc = VB + ((size_t)MTOK + (size_t)b * CTXL) * LDR + h * 128; const bf16_t* Vl = VB + ((size_t)b * SEQ + (size_t)krlo * 64) * LDR + h * 128;
    Stager st; st.init(tid);
    const int vb0 = (int)(uintptr_t)lds + v_rd_base(lane);
    f32x16 o[4];
#pragma unroll
    for (int d = 0; d < 4; ++d) o[d] = f32x16{};
    float l = 0.f;
    st.load(Kc, Vc); asm volatile("s_waitcnt vmcnt(0)" ::: "memory"); st.write(lds, 0); __syncthreads();
    for (int j = 0; j < NT; ++j) {
        const int cur = j & 1;
        if (j + 1 < NT) { const int t = j + 1; if (t < 4) st.load(Kc + (size_t)t * 64 * LDR, Vc + (size_t)t * 64 * LDR); else st.load(Kl + (size_t)(t - 4) * 64 * LDR, Vl + (size_t)(t - 4) * 64 * LDR); }
        const int kr = krlo + j - 4;
        const bool active = (j < 4) || (kr >= rs0 && kr <= rs0 + 7);
        if (active) {
            const char* Ks = lds + 2 * SHM_V + cur * SHM_K; const int vb = vb0 + cur * SHM_V;
            f32x16 p0, p1; bf16x8 pa0, pa1, pa2, pa3;
            qkt<0, 8>(p0, p1, Ks, qr, r32, hi);
            if (j >= 4) {
                const float* brow = bias + (kr - rq + 7) * 128 + 48 + (15 - qc + 4 * hi); const int dc = 4 * hi - cs;
                float ps = 0.f;
#pragma unroll
                for (int r = 0; r < 16; ++r) { const int c0 = (r & 3) + 8 * (r >> 2);
                    if (H == 0 || r >= 12) { const float s0 = p0[r] + brow[c0]; p0[r] = ((unsigned)(c0 + dc) < 16u) ? __builtin_amdgcn_exp2f(s0) : 0.f; } else p0[r] = 0.f;
                    if (H == 1 || r < 4) { const float s1 = p1[r] + brow[c0 + 32]; p1[r] = ((unsigned)(c0 + 32 + dc) < 16u) ? __builtin_amdgcn_exp2f(s1) : 0.f; } else p1[r] = 0.f;
                    SBAR(); }
#pragma unroll
                for (int r = 0; r < 16; ++r) { if (H == 0 || r >= 12) ps += p0[r]; if (H == 1 || r < 4) ps += p1[r]; }
                l += ps; SBAR();
                if (H == 0) { pa0 = pk4f<0>(p0); pa1 = pk4f<8>(p0); pa2 = pk4f<0>(p1); } else { pa1 = pk4f<8>(p0); pa2 = pk4f<0>(p1); pa3 = pk4f<8>(p1); }
            } else {
#pragma unroll
                for (int r = 0; r < 16; ++r) { p0[r] = __builtin_amdgcn_exp2f(p0[r]); p1[r] = __builtin_amdgcn_exp2f(p1[r]); }
                { float ps = 0.f;
#pragma unroll
                  for (int r = 0; r < 16; ++r) ps += p0[r] + p1[r];
                  l += ps; }
                pack_p(p0, p1, pa0, pa1, pa2, pa3);
            }
            SBAR();
            if (H == 0) { pv_one3<0, 0>(o[0], vb, pa0, pa1, pa2); pv_one3<1, 0>(o[1], vb, pa0, pa1, pa2); pv_one3<2, 0>(o[2], vb, pa0, pa1, pa2); pv_one3<3, 0>(o[3], vb, pa0, pa1, pa2); }
            else        { pv_one3<0, 1>(o[0], vb, pa1, pa2, pa3); pv_one3<1, 1>(o[1], vb, pa1, pa2, pa3); pv_one3<2, 1>(o[2], vb, pa1, pa2, pa3); pv_one3<3, 1>(o[3], vb, pa1, pa2, pa3); }
            if (j < 4) { const bf16x8 px = (H == 0) ? pa3 : pa0;
                pv_one1<0, H == 0 ? 3 : 0>(o[0], vb, px); pv_one1<1, H == 0 ? 3 : 0>(o[1], vb, px); pv_one1<2, H == 0 ? 3 : 0>(o[2], vb, px); pv_one1<3, H == 0 ? 3 : 0>(o[3], vb, px); }
        }
        if (j + 1 < NT) { asm volatile("s_waitcnt vmcnt(0)" ::: "memory"); st.write(lds, cur ^ 1); }
        __syncthreads();
    }
    l = half_sum(l);
    if (hi == 0) ws[r32] = l; asm volatile("s_waitcnt lgkmcnt(0)" ::: "memory");
#pragma unroll
    for (int r = 0; r < 16; ++r) { const int orow = crow(r, hi); const float il = __builtin_amdgcn_rcpf(ws[orow]);
        bf16_t* yp = Y + (qrow0 + orow) * DM + 1024 + h * 128 + r32;
#pragma unroll
        for (int d = 0; d < 4; ++d) { const unsigned w = cvtpk(o[d][r] * il, 0.f); yp[d * 32] = (bf16_t)(w & 0xffffu); } }
    __syncthreads();
}
#undef KSWZ
#undef SBAR
__device__ __forceinline__ void na_unit(int b, int h, int rb, const bf16_t* QB, const bf16_t* KB, const bf16_t* VB, bf16_t* Y, const float* rpb, char* lds) {
    const int wid = __builtin_amdgcn_readfirstlane((int)threadIdx.x >> 6);
    if (wid & 1) na_unit_h<1>(b, h, rb, QB, KB, VB, Y, rpb, lds); else na_unit_h<0>(b, h, rb, QB, KB, VB, Y, rpb, lds);
}
}

constexpr int NWAVES = 8;
constexpr int N_LAUNCHES = MK_N_LAUNCHES;
constexpr int PER_PHASE = 13;
static_assert(N_LAUNCHES == 1 || N_LAUNCHES == PER_PHASE, "MK_N_LAUNCHES is 1 or 13");

constexpr size_t MiB = 1u << 20;
constexpr size_t WS_CTL = 0, CTL_ZERO_BYTES = 1 * MiB;
constexpr size_t WS_MOD = 1 * MiB;
constexpr size_t WS_GAINS = 1 * MiB + 384 * 1024;
constexpr size_t WS_ROPE = 1 * MiB + 512 * 1024;
constexpr size_t WS_WIN = 2 * MiB, WS_WAB = 42 * MiB, WS_WO = 50 * MiB, WS_WGU = 58 * MiB, WS_WD = 314 * MiB;
constexpr size_t WS_ROWSQ = 442 * MiB;
constexpr size_t WS_AFF = 446 * MiB;
constexpr size_t WS_TOK = 448 * MiB;
constexpr size_t WS_GSEL = WS_TOK + 256 * 1024;
constexpr size_t WS_INV = 449 * MiB;
constexpr size_t WS_H = 452 * MiB;
constexpr size_t WS_PB = 584 * MiB, PB_STRIDE = 66 * MiB;
constexpr size_t WS_GATE = 980 * MiB;
constexpr size_t WS_U = WS_PB;
constexpr size_t WS_XE = WS_PB + 2 * PB_STRIDE;
constexpr size_t WS_END = 1236 * MiB;
static_assert(WS_H + (size_t)MALL * DM * 2 <= WS_PB && WS_PB + 6 * PB_STRIDE <= WS_GATE && WS_GATE + (size_t)MTOK * 4096 * 2 <= WS_END, "d_ws map");
static_assert(WS_U + (size_t)MTOK * UP * 2 <= WS_XE && WS_XE + (size_t)MSLOT * DM * 2 <= WS_GATE && (size_t)MALL * 1024 * 2 <= PB_STRIDE, "d_ws overlays");
static_assert(WS_WD + (size_t)NE * DM * FF * 2 <= WS_ROWSQ && WS_INV + (size_t)MTOK * 16 * 4 <= WS_H, "d_ws map 2");
constexpr int CW_TMO = 0, CW_CODE = 1, CW_BAR = 4096;

constexpr int RING_OFF = 0, RING_BYTES = 131072;
constexpr int LDSCTL_OFF = RING_BYTES, MISC_OFF = LDSCTL_OFF + 320;
constexpr int LDS_BYTES = 147456;
constexpr int EPI_X_OFF = 136192;
static_assert(EPI_X_OFF >= att::LDS_ATT_BYTES && EPI_X_OFF + 8192 <= LDS_BYTES, "LDS map: epilogue exchange table");
static_assert(MISC_OFF + 128 <= att::LDS_WS && att::LDS_ATT_BYTES <= LDS_BYTES && att::NSLOT * att::SLOT <= RING_BYTES, "LDS map");

#define GAS __attribute__((address_space(1)))
#define LAS __attribute__((address_space(3)))
typedef unsigned short bf16;
typedef unsigned v4u __attribute__((ext_vector_type(4)));
typedef unsigned v2u __attribute__((ext_vector_type(2)));
typedef float f32x4 __attribute__((ext_vector_type(4)));
typedef GAS unsigned gu32;
#define RLX_AGENT __ATOMIC_RELAXED, __HIP_MEMORY_SCOPE_AGENT
#define LDS_WAIT() asm volatile("s_waitcnt lgkmcnt(0)" ::: "memory")
#define VM_WAIT() asm volatile("s_waitcnt vmcnt(0)" ::: "memory")
__device__ __forceinline__ unsigned f2bf(float f) { unsigned u = __builtin_bit_cast(unsigned, f); return (u + 0x7fffu + ((u >> 16) & 1u)) >> 16; }
__device__ __forceinline__ unsigned pk2(float lo, float hi) { return f2bf(lo) | (f2bf(hi) << 16); }
__device__ __forceinline__ float bflo(unsigned w) { return __uint_as_float(w << 16); }
__device__ __forceinline__ float bfhi(unsigned w) { return __uint_as_float(w & 0xffff0000u); }

#define XB_TMO      128
#define XB_XCNT(j)  (256  + 64 * (j))
#define XB_XSUB(j)  (1280 + 64 * (j))
#define XB_XGEN(j)  (2304 + 64 * (j))
#define XB_TOP      3328
#define XB_TOPGEN   3392
#define XCD_BAR_WORDS 3456
#define XB_SPIN_CAP (1u << 18)

__device__ __forceinline__ unsigned xb_ld(unsigned* p)              { return __hip_atomic_load(p, __ATOMIC_RELAXED, __HIP_MEMORY_SCOPE_AGENT); }
__device__ __forceinline__ unsigned xb_add(unsigned* p, unsigned v) { return __hip_atomic_fetch_add(p, v, __ATOMIC_RELAXED, __HIP_MEMORY_SCOPE_AGENT); }
__device__ __forceinline__ unsigned xb_xcc_id() { return (unsigned)__builtin_amdgcn_s_getreg((3 << 11) | 20) & 0xFu; }
#define XB_SPIN(cond, bar) do { unsigned _sp = 0; while (cond) { __builtin_amdgcn_s_sleep(1); \
    if ((++_sp & 255u) == 0u) { if (xb_ld(&(bar)[XB_TMO])) break; if (_sp > XB_SPIN_CAP) { atomicAdd(&(bar)[XB_TMO], 1u); break; } } } } while (0)

struct XcdBarrier {
    unsigned* bar; unsigned x;
    volatile LAS unsigned* st;
};

__device__ __forceinline__ XcdBarrier xcd_barrier_post(unsigned* bar, volatile LAS unsigned* st) {
    XcdBarrier b; b.bar = bar; b.x = xb_xcc_id(); b.st = st;
    if (threadIdx.x == 0) (void)xb_add(&bar[XB_XCNT(b.x)], 1u);
    return b;
}
__device__ __forceinline__ void xcd_barrier_complete(unsigned* bar, unsigned x, unsigned& nloc, unsigned& nx) {
    const unsigned G = gridDim.x * gridDim.y * gridDim.z;
    unsigned sum, cnt, mine, sp = 0u;
    for (;;) {
        sum = 0u; cnt = 0u; mine = 0u;
#pragma unroll
        for (unsigned j = 0; j < 16; ++j) { const unsigned c = xb_ld(&bar[XB_XCNT(j)]); sum += c; cnt += (c > 0u) ? 1u : 0u; mine = (j == x) ? c : mine; }
        if (sum == G) break;
        __builtin_amdgcn_s_sleep(1);
        if ((++sp & 255u) == 0u) { if (xb_ld(&bar[XB_TMO])) break; if (sp > XB_SPIN_CAP) { atomicAdd(&bar[XB_TMO], 1u); break; } }
    }
    nloc = mine > 0u ? mine : 1u; nx = cnt > 0u ? cnt : 1u;
}

__device__ __forceinline__ void xcd_barrier(const XcdBarrier& b) {
    asm volatile("s_waitcnt vmcnt(0)" ::: "memory");
    __syncthreads();
    if (threadIdx.x == 0) {
        unsigned* bar = b.bar;
        __builtin_amdgcn_s_waitcnt(0);
        unsigned nloc = b.st[0], nx = b.st[1];
        if (nloc == 0u) { xcd_barrier_complete(bar, b.x, nloc, nx); b.st[0] = nloc; b.st[1] = nx; }
        const unsigned old = xb_add(&bar[XB_XSUB(b.x)], 1u);
        const unsigned gen = old / nloc;
        if (old + 1u == (gen + 1u) * nloc) {
            __builtin_amdgcn_fence(__ATOMIC_RELEASE, "agent");
            asm volatile("s_waitcnt vmcnt(0)" ::: "memory");
            const unsigned og = xb_add(&bar[XB_TOP], 1u);
            const unsigned tg = og / nx;
            if (og + 1u == (tg + 1u) * nx) xb_add(&bar[XB_TOPGEN], 1u);
            else XB_SPIN(xb_ld(&bar[XB_TOPGEN]) == tg, bar);
            __builtin_amdgcn_fence(__ATOMIC_ACQUIRE, "agent");
            xb_add(&bar[XB_XGEN(b.x)], 1u);
            asm volatile("s_waitcnt vmcnt(0)" ::: "memory");
        } else {
            XB_SPIN(xb_ld(&bar[XB_XGEN(b.x)]) == gen, bar);
            __builtin_amdgcn_fence(__ATOMIC_ACQUIRE, "agent");
            asm volatile("s_waitcnt vmcnt(0)" ::: "memory");
        }
    }
    __syncthreads();
}

struct Frame {
    LAS unsigned char* lds;
    volatile LAS unsigned* MISC;
    gu32* ctl;
    int wave;
    int vcu, G;
};
struct Args {
    const float* in[26]; float* out; unsigned char* ws; int ph_lo, ph_hi, li, pad;
};
enum InIdx { I_X = 0, I_C, I_CTX, I_CCTX, I_WMOD, I_BMOD, I_G1, I_G2, I_WIN, I_QGA, I_KGA, I_LQ1, I_LK1, I_LQ2, I_LK2, I_SUBLN, I_QGB, I_KGB, I_RPB, I_WA, I_WB, I_WOUT, I_WR, I_WEG, I_WEU, I_WED };

__device__ __forceinline__ int ph_tid() { int t = threadIdx.x; asm volatile("" : "+v"(t)); return t; }
__device__ __forceinline__ float wave_sum(float v) {
#pragma unroll
    for (int o = 1; o < 64; o <<= 1) v += __shfl_xor(v, o);
    return v;
}
__device__ __forceinline__ float silu_f(float v) { return v / (1.0f + __expf(-v)); }

__device__ __forceinline__ void p0_mod(Frame& F, const Args& a, float* mod) {
    const int tid = ph_tid(), lane = tid & 63; (void)lane;
    LAS float* sv = (LAS float*)(F.lds + RING_OFF);
    LAS float* red = (LAS float*)(F.lds + RING_OFF + 40960);
    const float* c = a.in[I_C]; const float* cctx = a.in[I_CCTX]; const float* wmod = a.in[I_WMOD]; const float* bmod = a.in[I_BMOD];
    for (int i = tid; i < 5 * DM; i += NWAVES * 64) { const int r = i / DM, k = i % DM; sv[i] = silu_f(r < 4 ? c[r * DM + k] : cctx[k]); }
    __syncthreads();
    for (int s = blockIdx.x; s < 256; s += F.G) {
        const int cg = tid % 12, kl = tid / 12;
        float acc[5][4];
#pragma unroll
        for (int r = 0; r < 5; ++r)
#pragma unroll
            for (int e = 0; e < 4; ++e) acc[r][e] = 0.f;
        if (kl < 42) {
            for (int k = kl; k < DM; k += 42) { const f32x4 w = *(const f32x4*)(wmod + (size_t)k * 12288 + 48 * s + 4 * cg);
#pragma unroll
                for (int r = 0; r < 5; ++r) { const float sk = sv[r * DM + k];
#pragma unroll
                    for (int e = 0; e < 4; ++e) acc[r][e] += sk * w[e]; } }
#pragma unroll
            for (int r = 0; r < 5; ++r)
#pragma unroll
                for (int e = 0; e < 4; ++e) red[(kl * 12 + cg) * 20 + r * 4 + e] = acc[r][e];
        }
        __syncthreads();
        if (tid < 240) { const int r = tid / 48, col = tid % 48, g = col >> 2, e = col & 3; float t = 0.f;
            for (int q = 0; q < 42; ++q) t += red[(q * 12 + g) * 20 + r * 4 + e];
            mod[(size_t)r * 12288 + 48 * s + col] = t + bmod[48 * s + col]; }
        __syncthreads();
    }
}
__device__ __forceinline__ size_t b_tile_off(int drow, int k, int ntk, bool perm) {
    const int pn = drow >> 8, nl = drow & 255, h = nl >> 7, r = nl & 127, w = r & 31;
    const int rho = perm ? (r & ~31) + (16 * ((w >> 2) & 1) + 4 * (w >> 3) + (w & 3)) : r;
    return ((((size_t)pn * ntk + (k >> 6)) * 2 + h) * 16384 + (size_t)pg8::lds_byte(rho, k & 63)) >> 1;
}
__device__ __forceinline__ void p0_transpose_item(const float* W, int ldw, int k0, int n0, bf16* WT, int ldt, int drow0, int kdst0, LAS float* scr, int lane, bool perm) {
#pragma unroll 8
    for (int i = 0; i < 32; ++i) { const int kk = 2 * i + (lane >> 5); scr[kk * 33 + (lane & 31)] = W[(size_t)(k0 + kk) * ldw + n0 + (lane & 31)]; }
    LDS_WAIT(); asm volatile("" ::: "memory");
    const int c = lane & 7;
#pragma unroll
    for (int j = 0; j < 4; ++j) { const int n = (lane >> 3) + 8 * j; const LAS float* s = scr + (8 * c) * 33 + n;
        v4u o; o.x = pk2(s[0 * 33], s[1 * 33]); o.y = pk2(s[2 * 33], s[3 * 33]); o.z = pk2(s[4 * 33], s[5 * 33]); o.w = pk2(s[6 * 33], s[7 * 33]);
        *(GAS v4u*)(WT + b_tile_off(drow0 + n, kdst0 + k0 + 8 * c, ldt >> 6, perm)) = o; }
    LDS_WAIT(); asm volatile("" ::: "memory");
}
__device__ __forceinline__ void p0_expert_item(const Args& a, int r, LAS float* scr, int lane) {
    constexpr int I_E = 32 * 64;
    bf16* Wgu = (bf16*)(a.ws + WS_WGU); bf16* Wd = (bf16*)(a.ws + WS_WD);
    const int which = r / (NE * I_E); r -= which * (NE * I_E);
    const int e = r / I_E; r -= e * I_E; const int kb = r / 64, nb = r % 64, n0 = 32 * nb;
    if (which == 0)      p0_transpose_item(a.in[I_WEG] + (size_t)e * DM * FF, FF, 64 * kb, n0, Wgu + (size_t)e * 2 * FF * DM, DM, 256 * (n0 >> 7) + (n0 & 127), 0, scr, lane, true);
    else if (which == 1) p0_transpose_item(a.in[I_WEU] + (size_t)e * DM * FF, FF, 64 * kb, n0, Wgu + (size_t)e * 2 * FF * DM, DM, 256 * (n0 >> 7) + 128 + (n0 & 127), 0, scr, lane, true);
    else                 p0_transpose_item(a.in[I_WED] + (size_t)e * FF * DM, DM, 64 * kb, n0, Wd + (size_t)e * DM * FF, FF, n0, 0, scr, lane, true);
}
constexpr int X_ITEMS = 3 * NE * 32 * 64, XE0 = X_ITEMS - 36864, XE1 = X_ITEMS - 12288;
__device__ __forceinline__ void p0_expert_range(Frame& F, const Args& a, int lo, int hi, int w, int nw) {
    const int tid = ph_tid(), lane = tid & 63; (void)lane;
    LAS float* scr = (LAS float*)(F.lds + RING_OFF + F.wave * 16384);
    for (int r = lo + w; r < hi; r += nw) p0_expert_item(a, r, scr, lane);
}
__device__ __forceinline__ void p0_weights(Frame& F, const Args& a) {
    const int tid = ph_tid(), lane = tid & 63; (void)lane;
    LAS float* scr = (LAS float*)(F.lds + RING_OFF + F.wave * 16384);
    const int gw = F.vcu * NWAVES + F.wave, NGW = F.G * NWAVES;
    bf16* Win = (bf16*)(a.ws + WS_WIN); bf16* Wab = (bf16*)(a.ws + WS_WAB); bf16* Wo = (bf16*)(a.ws + WS_WO);
    constexpr int I_IN = 32 * 320, I_A = 16 * 64, I_O = 32 * 64;
    constexpr int NX = I_IN + 2 * I_A + I_O;
    const int nitems = NX + (F.G == 256 ? XE0 : X_ITEMS);
    for (int it = gw; it < nitems; it += NGW) {
        int r = it;
        if (r < I_IN) { const int kb = r / 320, nb = r % 320; int dr = 32 * nb;
            if (dr >= 2048 && dr < 6144) { const int isb = dr >= 4096 ? 1 : 0, c = dr - 2048 - 2048 * isb; dr = 2048 + 256 * (c >> 7) + 128 * isb + (c & 127); }
            p0_transpose_item(a.in[I_WIN], PROJ, 64 * kb, 32 * nb, Win, DM, dr, 0, scr, lane, true); continue; } r -= I_IN;
        if (r < I_A) { const int kb = r / 64, nb = r % 64; p0_transpose_item(a.in[I_WA], DM, 64 * kb, 32 * nb, Wab, DM, 32 * nb, 0, scr, lane, true); continue; } r -= I_A;
        if (r < I_A) { const int kb = r / 64, nb = r % 64; p0_transpose_item(a.in[I_WB], DM, 64 * kb, 32 * nb, Wab, DM, 32 * nb, 1024, scr, lane, true); continue; } r -= I_A;
        if (r < I_O) { const int kb = r / 64, nb = r % 64; p0_transpose_item(a.in[I_WOUT], DM, 64 * kb, 32 * nb, Wo, DM, 32 * nb, 0, scr, lane, false); continue; } r -= I_O;
        p0_expert_item(a, r, scr, lane);
    }
}
__device__ __forceinline__ void p1_norm1(Frame& F, const Args& a) {
    const int tid = ph_tid(), lane = tid & 63; (void)lane;
    const int gw = F.vcu * NWAVES + F.wave, NGW = F.G * NWAVES;
    const float* mod = (const float*)(a.ws + WS_MOD); const float* g1 = a.in[I_G1]; bf16* H = (bf16*)(a.ws + WS_H);
#define P1_XROW(m) ((const GAS f32x4*)((m) < MTOK ? a.in[I_X] + (size_t)(m) * DM : a.in[I_CTX] + (size_t)((m) - MTOK) * DM) + lane)
    f32x4 v[8];
    { const GAS f32x4* xr = P1_XROW(gw < MALL ? gw : 0);
#pragma unroll
      for (int j = 0; j < 8; ++j) v[j] = xr[64 * j]; }
    for (int m = gw; m < MALL; m += NGW) {
        const float* mr = mod + (size_t)(m < MTOK ? m / SEQ : 4) * 12288;
        f32x4 g[8], sh[8], sc[8], vn[8];
#pragma unroll
        for (int j = 0; j < 8; ++j) { const int c0 = 4 * lane + 256 * j; g[j] = *(const f32x4*)(g1 + c0); sh[j] = *(const f32x4*)(mr + c0); sc[j] = *(const f32x4*)(mr + 2048 + c0); }
        { const int mn = m + NGW; const GAS f32x4* xr = P1_XROW(mn < MALL ? mn : m);
#pragma unroll
          for (int j = 0; j < 8; ++j) vn[j] = xr[64 * j]; }
        __builtin_amdgcn_sched_barrier(0);
        float s = 0.f;
#pragma unroll
        for (int j = 0; j < 8; ++j) s += (v[j].x * v[j].x + v[j].y * v[j].y) + (v[j].z * v[j].z + v[j].w * v[j].w);
        const float rstd = 1.0f / sqrtf(wave_sum(s) * (1.0f / DM) + EPS);
        GAS v2u* o8 = (GAS v2u*)(H + (size_t)m * DM) + lane;
#pragma unroll
        for (int j = 0; j < 8; ++j) { const f32x4 y = (v[j] * rstd * g[j]) * (sc[j] + 1.0f) + sh[j];
            v2u w; w.x = pk2(y.x, y.y); w.y = pk2(y.z, y.w); o8[64 * j] = w; }
#pragma unroll
        for (int j = 0; j < 8; ++j) v[j] = vn[j];
    }
#undef P1_XROW
}
__device__ __forceinline__ void p3_qknorm(Frame& F, const Args& a) {
    const int tid = ph_tid(), lane = tid & 63; (void)lane;
    LAS float* tab = (LAS float*)(F.lds + RING_OFF);
    for (int i = tid; i < 128 * 16; i += NWAVES * 64) { const int p = i >> 4, f = i & 15; const float inv = exp2f(-(float)f * (13.287712379549449f / 16.0f));
        const float ang = (float)p * inv; tab[2 * i] = cosf(ang); tab[2 * i + 1] = sinf(ang); }
    __syncthreads();
    const int gw = F.vcu * NWAVES + F.wave, NGW = F.G * NWAVES;
    constexpr int NITEM = 2 * MTOK + 2 * MALL;
    for (int it = gw; it < NITEM; it += NGW) {
        int which, row;
        if (it < MTOK) { which = 0; row = it; } else if (it < 2 * MTOK) { which = 1; row = it - MTOK; } else if (it < 2 * MTOK + MALL) { which = 2; row = it - 2 * MTOK; } else { which = 3; row = it - 2 * MTOK - MALL; }
        if (which == 1 || which == 3) continue;
        const int bufi = which == 0 ? 0 : which == 1 ? 1 : which == 2 ? 2 : 4;
        bf16* p = (bf16*)(a.ws + WS_PB + (size_t)bufi * PB_STRIDE) + (size_t)row * 1024 + 16 * lane;
        const v4u w0 = *(const GAS v4u*)p, w1 = *(const GAS v4u*)(p + 8);
        float v[16];
        v[0] = bflo(w0.x); v[1] = bfhi(w0.x); v[2] = bflo(w0.y); v[3] = bfhi(w0.y); v[4] = bflo(w0.z); v[5] = bfhi(w0.z); v[6] = bflo(w0.w); v[7] = bfhi(w0.w);
        v[8] = bflo(w1.x); v[9] = bfhi(w1.x); v[10] = bflo(w1.y); v[11] = bfhi(w1.y); v[12] = bflo(w1.z); v[13] = bfhi(w1.z); v[14] = bflo(w1.w); v[15] = bfhi(w1.w);
        float ss = 0.f;
#pragma unroll
        for (int i = 0; i < 16; ++i) ss += v[i] * v[i];
        const bool isA = (which == 0 || which == 2);
        ss += __shfl_xor(ss, 1); ss += __shfl_xor(ss, 2);
        float rstd;
        if (isA) rstd = 1.0f / sqrtf(ss * (1.0f / 64.0f) + EPS);
        else { ss += __shfl_xor(ss, 4); rstd = 1.0f / sqrtf(ss * (1.0f / 128.0f) + EPS); }
        const float* gain = a.in[which == 0 ? I_QGA : which == 1 ? I_QGB : which == 2 ? I_KGA : I_KGB] + 16 * (isA ? (lane & 3) : (lane & 7));
        const float qs = which == 0 ? 0.125f * LOG2E : which == 1 ? 0.08838834764831845f * LOG2E : 1.0f;
#pragma unroll
        for (int i = 0; i < 16; ++i) v[i] = v[i] * rstd * gain[i];
        if (isA && row < MTOK) {
            const int t = row % SEQ, j = lane & 3, pos = (j < 2) ? (t / GRIDW) : (t % GRIDW);
            const LAS float* tp = tab + pos * 32;
#pragma unroll
            for (int i = 0; i < 16; ++i) { const float other = __shfl_xor(v[i], 1); const float cs = tp[2 * i], sn = tp[2 * i + 1];
                v[i] = (j & 1) ? (v[i] * cs + other * sn) : (v[i] * cs - other * sn); }
        }
        v4u o0, o1;
        o0.x = pk2(v[0] * qs, v[1] * qs); o0.y = pk2(v[2] * qs, v[3] * qs); o0.z = pk2(v[4] * qs, v[5] * qs); o0.w = pk2(v[6] * qs, v[7] * qs);
        o1.x = pk2(v[8] * qs, v[9] * qs); o1.y = pk2(v[10] * qs, v[11] * qs); o1.z = pk2(v[12] * qs, v[13] * qs); o1.w = pk2(v[14] * qs, v[15] * qs);
        *(GAS v4u*)p = o0; *(GAS v4u*)(p + 8) = o1;
    }
    __syncthreads();
}
__device__ __forceinline__ void p7_norm2_router(Frame& F, const Args& a) {
    const int tid = ph_tid(), lane = tid & 63; (void)lane;
    typedef float f4 __attribute__((ext_vector_type(4)));
    const int gw = F.vcu * NWAVES + F.wave, NGW = F.G * NWAVES, fr = lane & 15, fq = lane >> 4;
    const float* mod = (const float*)(a.ws + WS_MOD); const float* g2 = a.in[I_G2]; const float* wr = a.in[I_WR]; const float* xn = a.out;
    const float* rowsq = (const float*)(a.ws + WS_ROWSQ); bf16* H2 = (bf16*)(a.ws + WS_H); float* aff = (float*)(a.ws + WS_AFF);
    for (int tile = gw; tile < MTOK / 16; tile += NGW) {
        const int row = tile * 16 + fr, b = (tile * 16) / SEQ;
        const float* mr = mod + (size_t)b * 12288;
        float ss = 0.f;
#pragma unroll
        for (int q = 0; q < 8; ++q) { const f4 t = *(const f4*)(rowsq + (size_t)row * 32 + 4 * q); ss += t.x; ss += t.y; ss += t.z; ss += t.w; }
        const float rstd = 1.0f / sqrtf(ss * (1.0f / DM) + EPS);
        f4 acc = {0.f, 0.f, 0.f, 0.f};
        const float* xr = xn + (size_t)row * DM + 4 * fq; bf16* hr = H2 + (size_t)row * DM + 4 * fq;
        for (int k8 = 0; k8 < DM / 16; k8 += 8) { f4 xv[8], g[8], sh[8], sc[8]; float w0[8], w1[8], w2[8], w3[8];
#pragma unroll
            for (int q = 0; q < 8; ++q) { const int kk = k8 + q, c0 = 16 * kk + 4 * fq; xv[q] = *(const f4*)(xr + 16 * kk); g[q] = *(const f4*)(g2 + c0); sh[q] = *(const f4*)(mr + 6144 + c0); sc[q] = *(const f4*)(mr + 8192 + c0);
                const float* wp = wr + (size_t)c0 * 16 + fr; w0[q] = wp[0]; w1[q] = wp[16]; w2[q] = wp[32]; w3[q] = wp[48]; }
            __builtin_amdgcn_sched_barrier(0);
#pragma unroll
            for (int q = 0; q < 8; ++q) { const int kk = k8 + q;
                const f4 hv = (xv[q] * rstd * g[q]) * (sc[q] + 1.0f) + sh[q];
                v2u w; w.x = pk2(hv.x, hv.y); w.y = pk2(hv.z, hv.w); *(GAS v2u*)(hr + 16 * kk) = w;
                acc = __builtin_amdgcn_mfma_f32_16x16x4f32(hv.x, w0[q], acc, 0, 0, 0);
                acc = __builtin_amdgcn_mfma_f32_16x16x4f32(hv.y, w1[q], acc, 0, 0, 0);
                acc = __builtin_amdgcn_mfma_f32_16x16x4f32(hv.z, w2[q], acc, 0, 0, 0);
                acc = __builtin_amdgcn_mfma_f32_16x16x4f32(hv.w, w3[q], acc, 0, 0, 0); } }
        f4 pr;
#pragma unroll
        for (int r = 0; r < 4; ++r) { float mx = acc[r];
            mx = fmaxf(mx, __shfl_xor(mx, 1)); mx = fmaxf(mx, __shfl_xor(mx, 2)); mx = fmaxf(mx, __shfl_xor(mx, 4)); mx = fmaxf(mx, __shfl_xor(mx, 8));
            const float ex = __expf(acc[r] - mx); float sm = ex;
            sm += __shfl_xor(sm, 1); sm += __shfl_xor(sm, 2); sm += __shfl_xor(sm, 4); sm += __shfl_xor(sm, 8);
            pr[r] = ex / sm; }
        const int n0 = (tile * 16) % SEQ + 4 * fq;
        *(f4*)(aff + ((size_t)(b * NE + fr)) * SEQ + n0) = pr;
    }
}
__device__ __forceinline__ void p8_topk(Frame& F, const Args& a) {
    const int tid = ph_tid(), lane = tid & 63; (void)lane;
    LAS unsigned* key = (LAS unsigned*)(F.lds + RING_OFF);
    LAS unsigned* hist = (LAS unsigned*)(F.lds + RING_OFF + 32768);
    LAS unsigned* sel = (LAS unsigned*)(F.lds + RING_OFF + 32768 + 1024);
    LAS unsigned* wsum = (LAS unsigned*)(F.lds + RING_OFF + 32768 + 2048);
    const float* aff = (const float*)(a.ws + WS_AFF); int* tok = (int*)(a.ws + WS_TOK); float* gsel = (float*)(a.ws + WS_GSEL); int* inv = (int*)(a.ws + WS_INV);
    const int wave = F.wave;
    for (int p = blockIdx.x; p < NB * NE; p += F.G) {
        const int b = p / NE, e = p % NE;
        const unsigned* src = (const unsigned*)(aff + (size_t)p * SEQ);
        for (int i = tid; i < SEQ; i += NWAVES * 64) key[i] = src[i];
        unsigned prefix = 0u, mask = 0u, krem = CAP;
        for (int pass = 0; pass < 4; ++pass) {
            const int shift = 24 - 8 * pass;
            if (tid < 256) hist[tid] = 0u;
            __syncthreads();
            for (int i = tid; i < SEQ; i += NWAVES * 64) { const unsigned k = key[i]; if ((k & mask) == prefix) atomicAdd((unsigned*)&hist[(k >> shift) & 255u], 1u); }
            __syncthreads();
            if (wave == 0) {
                unsigned h0 = hist[255 - 4 * lane], h1 = hist[254 - 4 * lane], h2 = hist[253 - 4 * lane], h3 = hist[252 - 4 * lane];
                const unsigned s = h0 + h1 + h2 + h3; unsigned inc = s;
#pragma unroll
                for (int o = 1; o < 64; o <<= 1) { const unsigned t = __shfl_up(inc, o); if (lane >= o) inc += t; }
                const unsigned exc = inc - s;
                if (exc < krem && krem <= inc) {
                    unsigned r = krem - exc; int bin;
                    if (r <= h0) bin = 255 - 4 * lane; else { r -= h0; if (r <= h1) bin = 254 - 4 * lane; else { r -= h1; if (r <= h2) bin = 253 - 4 * lane; else { r -= h2; bin = 252 - 4 * lane; } } }
                    sel[0] = (unsigned)bin; sel[1] = r; }
            }
            __syncthreads();
            prefix |= sel[0] << shift; mask |= 255u << shift; krem = sel[1];
            __syncthreads();
        }
        const unsigned T = prefix;
        unsigned cgt = 0u, ceq = 0u; unsigned kk[16];
#pragma unroll
        for (int i = 0; i < 16; ++i) { kk[i] = key[16 * tid + i]; cgt += kk[i] > T ? 1u : 0u; ceq += kk[i] == T ? 1u : 0u; }
        const unsigned pk = cgt | (ceq << 16); unsigned inc = pk;
#pragma unroll
        for (int o = 1; o < 64; o <<= 1) { const unsigned t = __shfl_up(inc, o); if (lane >= o) inc += t; }
        if (lane == 63) wsum[wave] = inc;
        __syncthreads();
        unsigned base = 0u;
        for (int w = 0; w < wave; ++w) base += wsum[w];
        const unsigned exc = base + inc - pk; unsigned ngt = exc & 0xffffu, neq = exc >> 16;
#pragma unroll
        for (int i = 0; i < 16; ++i) { const int n = 16 * tid + i; int slot = -1;
            if (kk[i] > T) { slot = (int)(ngt + (neq < krem ? neq : krem)); ++ngt; }
            else if (kk[i] == T) { if (neq < krem) slot = (int)(ngt + neq); ++neq; }
            inv[((size_t)b * SEQ + n) * NE + e] = slot;
            if (slot >= 0) { tok[(size_t)p * CAP + slot] = b * SEQ + n; gsel[(size_t)p * CAP + slot] = __uint_as_float(kk[i]); } }
        __syncthreads();
    }
}
__device__ __forceinline__ void p9_gather(Frame& F, const Args& a) {
    const int tid = ph_tid(), lane = tid & 63; (void)lane;
    const int gw = F.vcu * NWAVES + F.wave, NGW = F.G * NWAVES;
    const int* tok = (const int*)(a.ws + WS_TOK); const bf16* H2 = (const bf16*)(a.ws + WS_H); bf16* XE = (bf16*)(a.ws + WS_XE);
    for (int s = gw; s < MSLOT; s += NGW) { int sv = s; asm volatile("" : "+v"(sv)); const int t = tok[sv];
        const GAS v4u* src = (const GAS v4u*)(H2 + (size_t)t * DM) + lane; GAS v4u* dst = (GAS v4u*)(XE + (size_t)s * DM) + lane;
        const v4u v0 = src[0], v1 = src[64], v2 = src[128], v3 = src[192]; dst[0] = v0; dst[64] = v1; dst[128] = v2; dst[192] = v3; }
}
__device__ __forceinline__ void p12_combine(Frame& F, const Args& a) {
    const int tid = ph_tid(), lane = tid & 63; (void)lane;
    const int gw = F.vcu * NWAVES + F.wave, NGW = F.G * NWAVES;
    const int* inv = (const int*)(a.ws + WS_INV); const bf16* YM = (const bf16*)(a.ws + WS_XE); float* out = a.out;
    int myslot = -1, nslot = -1; f32x4 acc[8];
    if (gw < MTOK) myslot = inv[(size_t)gw * NE + (lane & 15)];
    if (gw + NGW < MTOK) nslot = inv[(size_t)(gw + NGW) * NE + (lane & 15)];
    if (gw < MTOK && (__ballot(myslot >= 0) & 0xffffull) != 0ull) {
#pragma unroll
        for (int j = 0; j < 8; ++j) acc[j] = *(const GAS f32x4*)(out + (size_t)gw * DM + 4 * lane + 256 * j); }
    for (int m = gw; m < MTOK; m += NGW) {
        const int b = m / SEQ; const int mn = m + NGW, mnn = m + 2 * NGW;
        int nnslot = -1; if (mnn < MTOK) nnslot = inv[(size_t)mnn * NE + (lane & 15)];
        f32x4 accn[8];
        const bool nneed = (__ballot(nslot >= 0) & 0xffffull) != 0ull;
        if (nneed) {
#pragma unroll
            for (int j = 0; j < 8; ++j) accn[j] = *(const GAS f32x4*)(out + (size_t)mn * DM + 4 * lane + 256 * j); }
        __builtin_amdgcn_sched_barrier(0);
        unsigned mask = (unsigned)(__ballot(myslot >= 0) & 0xffffull);
        const bool need = mask != 0u;
        while (mask) {
            const int e1 = __builtin_ctz(mask); mask &= mask - 1; const bool two = mask != 0u; const int e2 = two ? __builtin_ctz(mask) : e1; if (two) mask &= mask - 1;
            const int s1 = __shfl(myslot, e1), s2 = __shfl(myslot, e2);
            const bf16* y1 = YM + ((size_t)(b * NE + e1) * CAP + s1) * DM + 4 * lane; const bf16* y2 = YM + ((size_t)(b * NE + e2) * CAP + s2) * DM + 4 * lane;
            v2u w1[8], w2[8];
#pragma unroll
            for (int j = 0; j < 8; ++j) { w1[j] = *(const GAS v2u*)(y1 + 256 * j); w2[j] = *(const GAS v2u*)(y2 + 256 * j); }
            __builtin_amdgcn_sched_barrier(0);
#pragma unroll
            for (int j = 0; j < 8; ++j) { acc[j].x += bflo(w1[j].x); acc[j].y += bfhi(w1[j].x); acc[j].z += bflo(w1[j].y); acc[j].w += bfhi(w1[j].y);
                if (two) { acc[j].x += bflo(w2[j].x); acc[j].y += bfhi(w2[j].x); acc[j].z += bflo(w2[j].y); acc[j].w += bfhi(w2[j].y); } }
        }
        if (need) {
#pragma unroll
            for (int j = 0; j < 8; ++j) *(GAS f32x4*)(out + (size_t)m * DM + 4 * lane + 256 * j) = acc[j]; }
        myslot = nslot; nslot = nnslot;
        if (nneed) {
#pragma unroll
            for (int j = 0; j < 8; ++j) acc[j] = accn[j]; }
    }
}

__global__ void __launch_bounds__(NWAVES * 64, 2) fwd_kernel(Args args) {
    extern __shared__ __attribute__((aligned(16))) unsigned char lds[];
    Frame F;
    F.lds = (LAS unsigned char*)lds;
    F.MISC = (volatile LAS unsigned*)(F.lds + MISC_OFF);
    F.wave = __builtin_amdgcn_readfirstlane(threadIdx.x >> 6);
    F.G = gridDim.x; { const int bx = blockIdx.x; F.vcu = (F.G % 8 == 0) ? (bx % 8) * (F.G / 8) + bx / 8 : bx; }
    unsigned char* ws = args.ws;
    F.ctl = (gu32*)(ws + WS_CTL);
    for (int u = threadIdx.x; u < (LDS_BYTES - LDSCTL_OFF) / 4; u += NWAVES * 64) ((LAS unsigned*)(F.lds + LDSCTL_OFF))[u] = 0u;
    __syncthreads();
    XcdBarrier bar; bar.bar = (unsigned*)(F.ctl + CW_BAR); bar.x = 0; bar.st = nullptr;
    if (N_LAUNCHES != PER_PHASE) bar = xcd_barrier_post((unsigned*)(F.ctl + CW_BAR), F.MISC + 8);
#define GRID_BAR(seam) do { if (N_LAUNCHES == PER_PHASE) { if (threadIdx.x == 0) __hip_atomic_store(F.ctl + CW_TMO, 0xBADBA0u | (unsigned)(seam), RLX_AGENT); } else { xcd_barrier(bar); } } while (0)
    const int lo = args.ph_lo, hi = args.ph_hi;
#ifdef ONLY_PHASE
#define IN(k) ((k) == ONLY_PHASE && lo <= (k) && (k) < hi)
#else
#define IN(k) (lo <= (k) && (k) < hi)
#endif
#define BOTH(k) (IN(k) && IN((k) + 1))
    float* mod = (float*)(ws + WS_MOD);
    bf16* PB = (bf16*)(ws + WS_PB); constexpr size_t PBS = PB_STRIDE / 2;

    if (IN(0)) {
        if (blockIdx.x == 0) { float* rt = (float*)(ws + WS_ROPE);
            for (int i = threadIdx.x; i < 128 * 16; i += NWAVES * 64) { const int p = i >> 4, f = i & 15; const float inv = exp2f(-(float)f * (13.287712379549449f / 16.0f));
                const float ang = (float)p * inv; rt[2 * i] = cosf(ang); rt[2 * i + 1] = sinf(ang); }
            float* gn = (float*)(ws + WS_GAINS);
            if (threadIdx.x < 64) { gn[threadIdx.x] = args.in[I_QGA][threadIdx.x]; gn[256 + threadIdx.x] = args.in[I_KGA][threadIdx.x]; }
            if (threadIdx.x < 128) { gn[128 + threadIdx.x] = args.in[I_QGB][threadIdx.x]; gn[384 + threadIdx.x] = args.in[I_KGB][threadIdx.x]; } }
        p0_mod(F, args, mod); p0_weights(F, args); if (BOTH(0)) GRID_BAR(0); }
    if (IN(1)) { p1_norm1(F, args); if (BOTH(1)) GRID_BAR(1); }
    if (IN(2)) {
        pg8::Gemm g{(const bf16*)(ws + WS_H), (const bf16*)(ws + WS_WIN), MALL, PROJ, DM}; pg8::ProjOrder S; S.init(F.G, (int)blockIdx.x);
        pg8::EpiProj E{PB, PBS, (bf16*)(ws + WS_GATE), (LAS float*)(F.lds + EPI_X_OFF), (const float*)(ws + WS_GAINS), (const float*)(ws + WS_ROPE)};
        pg8::gemm_phase<pg8::EpiProj, pg8::ProjOrder, true, true>(F.lds + RING_OFF, g, S, E);
        if (F.G == 256 && blockIdx.x >= 64) { __syncthreads(); p0_expert_range(F, args, XE0, XE1, ((int)blockIdx.x - 64) * NWAVES + F.wave, 192 * NWAVES); }
        if (BOTH(2)) GRID_BAR(2);
    }
#if !FUSE_A
    if (IN(3)) { p3_qknorm(F, args); if (BOTH(3)) GRID_BAR(3); }
#endif
    if (IN(4)) {
        float lam;
        { const float* q1 = args.in[I_LQ1]; const float* k1 = args.in[I_LK1]; const float* q2 = args.in[I_LQ2]; const float* k2 = args.in[I_LK2];
          const int lane = ph_tid() & 63; const float s1 = wave_sum(q1[lane] * k1[lane]), s2 = wave_sum(q2[lane] * k2[lane]); lam = expf(s1) - expf(s2) + 0.2f; }
        bf16* Y = (bf16*)(ws + WS_H);
        const int bx = blockIdx.x;
        if (F.G == 256) {
            const int x = bx & 7, j = bx >> 3;
#ifndef NO_DIFF
            for (int i = 0; i < 8; ++i) att::diff_unit((x * 4 + (i >> 1)) >> 3, (x * 4 + (i >> 1)) & 7, (i & 1) * 32 + j, PB, PB + 2 * PBS, PB + 3 * PBS, Y, lam, args.in[I_SUBLN], (char*)lds + RING_OFF, F.lds + RING_OFF);
#endif
#ifndef NO_NA
            for (int i = 0; i < 4; ++i) att::na_unit((x * 4 + i) >> 3, (x * 4 + i) & 7, j, PB + PBS, PB + 4 * PBS, PB + 5 * PBS, Y, args.in[I_RPB], (char*)lds + RING_OFF);
#endif
        } else {
#ifndef NO_DIFF
            for (int uu = bx; uu < 2048; uu += F.G) att::diff_unit((uu >> 6) >> 3, (uu >> 6) & 7, uu & 63, PB, PB + 2 * PBS, PB + 3 * PBS, Y, lam, args.in[I_SUBLN], (char*)lds + RING_OFF, F.lds + RING_OFF);
#endif
#ifndef NO_NA
            for (int uu = bx; uu < 1024; uu += F.G) att::na_unit((uu >> 5) >> 3, (uu >> 5) & 7, uu & 31, PB + PBS, PB + 4 * PBS, PB + 5 * PBS, Y, args.in[I_RPB], (char*)lds + RING_OFF);
#endif
        }
        if (BOTH(4)) GRID_BAR(4);
    }
    if (IN(5)) {
        pg8::Gemm g{(const bf16*)(ws + WS_H), (const bf16*)(ws + WS_WAB), MTOK, DM, DM}; pg8::StaticOrder S; S.init(MTOK, DM, F.G, (int)blockIdx.x);
        pg8::EpiMerge E{(const bf16*)(ws + WS_GATE), (bf16*)(ws + WS_U)};
        pg8::gemm_phase<pg8::EpiMerge, pg8::StaticOrder, true, true>(F.lds + RING_OFF, g, S, E);
        if (BOTH(5)) GRID_BAR(5);
    }
    if (IN(6)) {
        pg8::Gemm g{(const bf16*)(ws + WS_U), (const bf16*)(ws + WS_WO), MTOK, DM, DM, UP}; pg8::StaticOrder S; S.init(MTOK, DM, F.G, (int)blockIdx.x);
        if (F.G == 256) {
            pg8::EpiWoDrain Ed{args.in[I_X], mod, args.out, (float*)(ws + WS_ROWSQ)}; pg8::OneUnitOrder S1; S1.so = S;
            S1.which = 0; pg8::gemm_phase<pg8::EpiWoDrain, pg8::OneUnitOrder, false, true>(F.lds + RING_OFF, g, S1, Ed); __syncthreads();
            S1.which = 1; pg8::gemm_phase<pg8::EpiWoDrain, pg8::OneUnitOrder, false, true>(F.lds + RING_OFF, g, S1, Ed); __syncthreads();
            S1.which = 2; pg8::gemm_phase<pg8::EpiWoDrain, pg8::OneUnitOrder, false, true>(F.lds + RING_OFF, g, S1, Ed); __syncthreads();
            S1.which = 3; pg8::gemm_phase<pg8::EpiWoDrain, pg8::OneUnitOrder, false, true>(F.lds + RING_OFF, g, S1, Ed); __syncthreads();
        } else {
        pg8::EpiWo E{args.in[I_X], mod, args.out, (float*)(ws + WS_ROWSQ)};
        pg8::gemm_phase<pg8::EpiWo, pg8::StaticOrder, true, true>(F.lds + RING_OFF, g, S, E);
        }
        if (BOTH(6)) GRID_BAR(6);
    }
    if (IN(7)) { p7_norm2_router(F, args); if (BOTH(7)) GRID_BAR(7); }
    if (IN(8)) { p8_topk(F, args); if (F.G == 256 && blockIdx.x >= 64) p0_expert_range(F, args, XE1, X_ITEMS, ((int)blockIdx.x - 64) * NWAVES + F.wave, 192 * NWAVES); if (BOTH(8)) GRID_BAR(8); }
    if (IN(10)) {
        pg8::Gemm g{(const bf16*)(ws + WS_H), (const bf16*)(ws + WS_WGU), MSLOT, 2 * FF, DM}; pg8::ExpertGatherOrder S; S.init(MSLOT, 2 * FF, F.G, (int)blockIdx.x); S.estride = (size_t)2 * FF * DM * 2; S.rowmap = (const int*)(ws + WS_TOK);
        pg8::EpiSwiglu E{(bf16*)(ws + WS_GATE)};
        pg8::gemm_phase<pg8::EpiSwiglu, pg8::ExpertGatherOrder, true, true>(F.lds + RING_OFF, g, S, E);
        if (BOTH(10)) GRID_BAR(10);
    }
    if (IN(11)) {
        pg8::Gemm g{(const bf16*)(ws + WS_GATE), (const bf16*)(ws + WS_WD), MSLOT, DM, FF}; pg8::ExpertOrder S; S.init(MSLOT, DM, F.G, (int)blockIdx.x); S.estride = (size_t)DM * FF * 2;
        pg8::EpiDown E{(const float*)(ws + WS_GSEL), mod, (bf16*)(ws + WS_XE)};
        pg8::gemm_phase<pg8::EpiDown, pg8::ExpertOrder, true, true>(F.lds + RING_OFF, g, S, E);
        if (BOTH(11)) GRID_BAR(11);
    }
    if (IN(12)) { p12_combine(F, args); }
#undef IN
#undef BOTH
}

extern "C" void kernel_launch(void* const* d_in, const int* in_sizes, int n_in, void* d_out, int out_size, void* d_ws, size_t ws_size, hipStream_t stream) {
    static int grid = 0;
    if (grid == 0) {
        if (n_in != 26 || in_sizes[0] != MTOK * DM || out_size != MTOK * DM || ws_size < WS_END) { fprintf(stderr, "kernel_launch: shape mismatch: n_in %d in0 %d out %d ws %zu (need %zu); nothing launched\n", n_in, n_in > 0 ? in_sizes[0] : -1, out_size, ws_size, (size_t)WS_END); grid = -1; return; }
        int dev = 0, cus = 0, per_cu = 0;
        if (hipGetDevice(&dev) != hipSuccess || hipDeviceGetAttribute(&cus, hipDeviceAttributeMultiprocessorCount, dev) != hipSuccess) { fprintf(stderr, "kernel_launch: device query failed\n"); grid = -1; return; }
        if (hipFuncSetAttribute((const void*)fwd_kernel, hipFuncAttributeMaxDynamicSharedMemorySize, LDS_BYTES) != hipSuccess) { fprintf(stderr, "kernel_launch: hipFuncSetAttribute failed\n"); grid = -1; return; }
        if (hipOccupancyMaxActiveBlocksPerMultiprocessor(&per_cu, (const void*)fwd_kernel, NWAVES * 64, LDS_BYTES) != hipSuccess || per_cu < 1)
            fprintf(stderr, "kernel_launch: note: occupancy query reports %d workgroups per CU\n", per_cu);
        (void)hipGetLastError();
        grid = cus;
    }
    if (grid < 0) return;
    if (hipMemsetAsync((char*)d_ws + WS_CTL, 0, CTL_ZERO_BYTES, stream) != hipSuccess) { fprintf(stderr, "kernel_launch: memset failed\n"); return; }
    Args a{};
    for (int i = 0; i < 26; ++i) a.in[i] = (const float*)d_in[i];
    a.out = (float*)d_out; a.ws = (unsigned char*)d_ws; a.pad = 0;
    for (int li = 0; li < N_LAUNCHES; ++li) {
        a.ph_lo = (N_LAUNCHES == PER_PHASE) ? li : 0; a.ph_hi = (N_LAUNCHES == PER_PHASE) ? li + 1 : PER_PHASE; a.li = li;
        hipLaunchKernelGGL(fwd_kernel, dim3(grid), dim3(NWAVES * 64), LDS_BYTES, stream, a);
        const hipError_t le = hipPeekAtLastError();
        if (le != hipSuccess) { fprintf(stderr, "kernel_launch: launch %d failed: %s\n", li, hipGetErrorName(le)); break; }
    }
}
```

```cpp
#include <hip/hip_runtime.h>
#include <cstdio>
#include <cstdint>

#ifndef MK_N_LAUNCHES
#define MK_N_LAUNCHES 1
#endif

constexpr int DM = 2048, NB = 4, SEQ = 8192, MTOK = NB * SEQ, CTXL = 256, MCTX = NB * CTXL, MALL = MTOK + MCTX;
constexpr int PROJ = 10240, NE = 16, FF = 2048, CAP = 1024, MSLOT = NB * NE * CAP;
constexpr int GRIDW = 64, GROWS = SEQ / GRIDW;
constexpr float EPS = 1e-6f;
constexpr int UP = DM + 64;
constexpr float LOG2E = 1.4426950408889634f;

namespace pg8 {
#define PG8_LAS __attribute__((address_space(3)))
typedef unsigned short bf16_t;
typedef short bf16x8 __attribute__((ext_vector_type(8)));
typedef float f32x4 __attribute__((ext_vector_type(4)));
typedef unsigned u32x4 __attribute__((ext_vector_type(4)));
typedef unsigned u32x2 __attribute__((ext_vector_type(2)));
constexpr int BM = 256, BK = 64, HALF = 128, HTB = HALF * BK * 2  , STAGE_BYTES = 8 * HTB, NXCD = 8, WGM = 8;

__host__ __device__ __forceinline__ int lds_byte(int r, int c) { const int st = (r >> 4) * 2 + (c >> 5), rr = r & 15, cc = c & 31, ob = rr * 64 + cc * 2; return st * 1024 + (ob ^ (((ob >> 9) & 1) << 5)); }
__host__ __device__ __forceinline__ void stage_rc(int b, int& R, int& C) { const int st = b / 1024, sb = b % 1024, swz = sb ^ (((sb >> 9) & 1) << 5); R = (st >> 1) * 16 + swz / 64; C = (st & 1) * 32 + (swz % 64) / 2; }
__host__ __device__ __forceinline__ int perm32(int rho) { const int n = rho >> 4, i = rho & 15; return 8 * (i >> 2) + 4 * n + (i & 3); }

struct Unit { int pm, pn; };
struct Gemm { const bf16_t* A; const bf16_t* Bt; int M, N, K; int lda = 0; };

struct StaticOrder {
    int nM, nN, nwg, G, c;
    __host__ __device__ void init(int M, int N, int G_, int c_) { nM = M / BM; nN = N / BM; nwg = nM * nN; G = G_; c = c_; }
    __host__ __device__ bool next(int i, Unit& u) const {
        const long L = (long)i * G + c; if (L >= nwg) return false;
        int wgid = (int)L; { const int q = nwg / NXCD, r = nwg % NXCD, xcd = wgid % NXCD, off = wgid / NXCD; wgid = (xcd < r ? xcd * (q + 1) : r * (q + 1) + (xcd - r) * q) + off; }
        const int nig = WGM * nN, gid = wgid / nig, fm = gid * WGM, gsz = (nM - fm) < WGM ? (nM - fm) : WGM;
        u.pm = fm + ((wgid % nig) % gsz); u.pn = (wgid % nig) / gsz;
        u.pn = (u.pn + (int)(L % NXCD) * nN / NXCD) % nN;
        return true;
    }
    __device__ __forceinline__ void a_ready(const Unit&) const {}
    __device__ __forceinline__ void done(const Unit&) const {}
    __device__ __forceinline__ size_t bofs(const Unit&) const { return 0; }
    static constexpr bool GATHER = false;
};
struct ProjOrder {
    StaticOrder so;
    __device__ void init(int G_, int c_) { so.init(MTOK, PROJ, G_, c_); }
    __device__ bool next(int i, Unit& u) const {
        if (so.next(i, u)) return true;
        const long j = (long)i * so.G + so.c - so.nwg; if (j < 0 || j >= 64) return false;
        u.pm = MTOK / BM + (int)(j >> 4); u.pn = 24 + (int)(j & 15); return true;
    }
    __device__ __forceinline__ void a_ready(const Unit&) const {}
    __device__ __forceinline__ void done(const Unit&) const {}
    __device__ __forceinline__ size_t bofs(const Unit&) const { return 0; }
    static constexpr bool GATHER = false;
};
struct OneUnitOrder {
    StaticOrder so; int which;
    __device__ bool next(int i, Unit& u) const { return i == 0 && so.next(which, u); }
    __device__ __forceinline__ void a_ready(const Unit&) const {}
    __device__ __forceinline__ void done(const Unit&) const {}
    __device__ __forceinline__ size_t bofs(const Unit&) const { return 0; }
    static constexpr bool GATHER = false;
};
struct ExpertOrder : StaticOrder {
    size_t estride;
    __device__ __forceinline__ size_t bofs(const Unit& u) const { return (size_t)((u.pm >> 2) & 15) * estride; }
};
struct ExpertGatherOrder : ExpertOrder {
    const int* rowmap;
    static constexpr bool GATHER = true;
};

typedef float f32x2_cv __attribute__((ext_vector_type(2))); typedef __bf16 bf16x2_cv __attribute__((ext_vector_type(2)));
__device__ __forceinline__ unsigned cvt_pk_bf16(float lo, float hi) { const f32x2_cv v = {lo, hi}; const bf16x2_cv b = __builtin_convertvector(v, bf16x2_cv); return __builtin_bit_cast(unsigned, b); }
__device__ __forceinline__ float bf_lo(unsigned w) { return __uint_as_float(w << 16); }
__device__ __forceinline__ float bf_hi(unsigned w) { return __uint_as_float(w & 0xffff0000u); }
__device__ __forceinline__ float sigmoidf_(float v) { return __builtin_amdgcn_rcpf(1.0f + __builtin_amdgcn_exp2f(-v * LOG2E)); }


#ifndef FUSE_A
#define FUSE_A 1
#endif
__device__ __forceinline__ size_t gate_off(int pm, int pg, int wave, int lane) { return ((((size_t)pm * 16 + pg) * 8 + wave) * 16) * 512 + (size_t)lane * 8; }
struct EpiProj {
    static constexpr bool PERM = true, AFTER_DRAIN = false, HAS_MID = false;
    bf16_t* pb; size_t pbs; bf16_t* gate;
    PG8_LAS float* X;
    const float* gains; const float* rtab;
    __device__ __forceinline__ void normed(const f32x4 (&acc)[2][2][4][2], const Unit& u, int wr, int wc, int fr, int fq, bf16_t* base, int colt, bool isA, bool isQ) const {
        const int rl0 = wr * 64 + fr;
#pragma unroll
        for (int ai = 0; ai < 2; ++ai)
#pragma unroll
            for (int m = 0; m < 4; ++m)
#pragma unroll
                for (int bj = 0; bj < 2; ++bj) { const f32x4 a0 = acc[ai][bj][m][0], a1 = acc[ai][bj][m][1];
                    float sq = ((a0[0] * a0[0] + a0[1] * a0[1]) + (a0[2] * a0[2] + a0[3] * a0[3])) + ((a1[0] * a1[0] + a1[1] * a1[1]) + (a1[2] * a1[2] + a1[3] * a1[3]));
                    sq += __shfl_xor(sq, 16); sq += __shfl_xor(sq, 32);
                    if (fq == 0) X[((rl0 + ai * HALF + m * 16) * 2 + bj) * 4 + wc] = sq; }
        asm volatile("s_waitcnt lgkmcnt(0)" ::: "memory"); __builtin_amdgcn_s_barrier(); asm volatile("" ::: "memory");
        const float* gain = gains + (isQ ? 0 : 256) + (isA ? 0 : 128);
        const int gd = (isA ? 32 * (wc & 1) : 32 * wc) + 8 * fq;
        const f32x4 g0 = *(const f32x4*)(gain + gd), g1 = *(const f32x4*)(gain + gd + 4);
        const float qs = isQ ? (isA ? 0.125f * LOG2E : 0.08838834764831845f * LOG2E) : 1.0f;
        const int row0 = u.pm * BM + rl0, col0 = colt + wc * 32 + 8 * fq;
        const bool rope = FUSE_A && isA && (u.pm < MTOK / BM);
#pragma unroll
        for (int ai = 0; ai < 2; ++ai)
#pragma unroll
            for (int m = 0; m < 4; ++m) { const int rl = rl0 + ai * HALF + m * 16, row = row0 + ai * HALF + m * 16; bf16_t* rowp = base + (size_t)row * 1024 + col0;
                f32x4 c0 = {1.f, 1.f, 1.f, 1.f}, s0 = {0.f, 0.f, 0.f, 0.f}, c1 = c0, s1 = s0;
                if (rope) { const int t = row % SEQ, pos = (wc & 1) ? (t % GRIDW) : (t / GRIDW); const float* tp = rtab + pos * 32 + 2 * (8 * (fq & 1));
                    const f32x4 t0 = *(const f32x4*)tp, t1 = *(const f32x4*)(tp + 4), t2 = *(const f32x4*)(tp + 8), t3 = *(const f32x4*)(tp + 12);
                    c0 = (f32x4){t0[0], t0[2], t1[0], t1[2]}; s0 = (f32x4){t0[1], t0[3], t1[1], t1[3]}; c1 = (f32x4){t2[0], t2[2], t3[0], t3[2]}; s1 = (f32x4){t2[1], t2[3], t3[1], t3[3]};
                    if (fq < 2) { s0 = -s0; s1 = -s1; } }
#pragma unroll
                for (int bj = 0; bj < 2; ++bj) { const PG8_LAS float* xp = X + (rl * 2 + bj) * 4;
                    const float tot = isA ? (xp[wc & ~1] + xp[wc | 1]) : (((xp[0] + xp[1]) + xp[2]) + xp[3]);
                    const float rstd = __builtin_amdgcn_rsqf(tot * (isA ? (1.0f / 64.0f) : (1.0f / 128.0f)) + EPS);
                    f32x4 v0 = acc[ai][bj][m][0] * rstd * g0, v1 = acc[ai][bj][m][1] * rstd * g1;
                    if (rope) { f32x4 o0, o1;
#pragma unroll
                        for (int e = 0; e < 4; ++e) { o0[e] = __shfl_xor(v0[e], 32); o1[e] = __shfl_xor(v1[e], 32); }
                        v0 = v0 * c0 + o0 * s0; v1 = v1 * c1 + o1 * s1; }
                    v0 = v0 * qs; v1 = v1 * qs;
                    u32x4 w; w.x = cvt_pk_bf16(v0[0], v0[1]); w.y = cvt_pk_bf16(v0[2], v0[3]); w.z = cvt_pk_bf16(v1[0], v1[1]); w.w = cvt_pk_bf16(v1[2], v1[3]);
                    *(u32x4*)(rowp + bj * HALF) = w; } }
    }
    __device__ __forceinline__ void operator()(const f32x4 (&acc)[2][2][4][2], const Unit& u, int wr, int wc, int fr, int fq) const {
        const int pn = u.pn; bf16_t* base; int ldc, colt; bool sig = false;
        if (pn < 8) { base = pb + (size_t)(pn >> 2) * pbs; colt = (pn & 3) * BM; ldc = 1024; }
        else if (pn < 24) { base = gate; colt = (pn - 8) * BM; ldc = 4096; sig = true; }
        else { base = pb + (size_t)(2 + ((pn - 24) >> 2)) * pbs; colt = ((pn - 24) & 3) * BM; ldc = 1024; }
        const bool isB = (pn >= 4 && pn < 8) || (pn >= 32 && pn < 36), isA = FUSE_A && (pn < 4 || (pn >= 24 && pn < 28));
        if (isA || isB) { normed(acc, u, wr, wc, fr, fq, base, colt, isA, pn < 8); return; }
        if (sig) {
            bf16_t* gp = gate + gate_off(u.pm, pn - 8, wr * 4 + wc, (fq << 4) | fr);
#pragma unroll
            for (int ai = 0; ai < 2; ++ai)
#pragma unroll
                for (int m = 0; m < 4; ++m) { f32x4 ra[2], sb[2];
#pragma unroll
                    for (int n = 0; n < 2; ++n)
#pragma unroll
                        for (int e = 0; e < 4; ++e) {
                            const float ea = 1.0f + __builtin_amdgcn_exp2f(fminf(-acc[ai][0][m][n][e] * LOG2E, 50.0f)), eb = 1.0f + __builtin_amdgcn_exp2f(fminf(-acc[ai][1][m][n][e] * LOG2E, 50.0f));
                            const float inv = __builtin_amdgcn_rcpf(ea * eb); sb[n][e] = inv * ea; ra[n][e] = eb * eb * inv; }
                    u32x4 w; w.x = cvt_pk_bf16(ra[0][0], ra[0][1]); w.y = cvt_pk_bf16(ra[0][2], ra[0][3]); w.z = cvt_pk_bf16(ra[1][0], ra[1][1]); w.w = cvt_pk_bf16(ra[1][2], ra[1][3]);
                    *(u32x4*)(gp + (ai * 4 + m) * 512) = w;
                    w.x = cvt_pk_bf16(sb[0][0], sb[0][1]); w.y = cvt_pk_bf16(sb[0][2], sb[0][3]); w.z = cvt_pk_bf16(sb[1][0], sb[1][1]); w.w = cvt_pk_bf16(sb[1][2], sb[1][3]);
                    *(u32x4*)(gp + (8 + ai * 4 + m) * 512) = w; }
            return; }
        const int row0 = u.pm * BM + wr * 64 + fr, col0 = colt + wc * 32 + 8 * fq;
#pragma unroll
        for (int ai = 0; ai < 2; ++ai)
#pragma unroll
            for (int m = 0; m < 4; ++m) { bf16_t* rowp = base + (size_t)(row0 + ai * HALF + m * 16) * ldc + col0;
#pragma unroll
                for (int bj = 0; bj < 2; ++bj) { const f32x4 v0 = acc[ai][bj][m][0], v1 = acc[ai][bj][m][1];
                    u32x4 w; w.x = cvt_pk_bf16(v0[0], v0[1]); w.y = cvt_pk_bf16(v0[2], v0[3]); w.z = cvt_pk_bf16(v1[0], v1[1]); w.w = cvt_pk_bf16(v1[2], v1[3]);
                    *(u32x4*)(rowp + bj * HALF) = w; } }
    }
};
struct EpiMerge {
    static constexpr bool PERM = true, AFTER_DRAIN = false, HAS_MID = true;
    const bf16_t* gate; bf16_t* U;
    __device__ __forceinline__ void mid(f32x4 (&acc)[2][2][4][2], const Unit& u, int wr, int wc, int fr, int fq) const {
        int ln = (fq << 4) | fr; asm volatile("" : "+v"(ln));
        const bf16_t* gp0 = gate + gate_off(u.pm, 2 * u.pn, wr * 4 + wc, ln); const bf16_t* gp1 = gate + gate_off(u.pm, 2 * u.pn + 1, wr * 4 + wc, ln);
        u32x4 r[2][4][2];
#pragma unroll
        for (int ai = 0; ai < 2; ++ai)
#pragma unroll
            for (int m = 0; m < 4; ++m) { r[ai][m][0] = *(const u32x4*)(gp0 + (ai * 4 + m) * 512); r[ai][m][1] = *(const u32x4*)(gp1 + (ai * 4 + m) * 512); }
#pragma unroll
        for (int ai = 0; ai < 2; ++ai)
#pragma unroll
            for (int m = 0; m < 4; ++m)
#pragma unroll
                for (int bj = 0; bj < 2; ++bj) { const u32x4 a = r[ai][m][bj];
                    const f32x4 r0 = {bf_lo(a.x), bf_hi(a.x), bf_lo(a.y), bf_hi(a.y)}, r1 = {bf_lo(a.z), bf_hi(a.z), bf_lo(a.w), bf_hi(a.w)};
                    acc[ai][bj][m][0] *= r0; acc[ai][bj][m][1] *= r1; }
        asm volatile("" ::: "memory");
    }
    __device__ __forceinline__ void operator()(const f32x4 (&acc)[2][2][4][2], const Unit& u, int wr, int wc, int fr, int fq) const {
        int row0 = u.pm * BM + wr * 64 + fr, col0 = u.pn * BM + wc * 32 + 8 * fq; asm volatile("" : "+v"(row0), "+v"(col0));
        u32x4 gb[2][4][2]; const int ln = (fq << 4) | fr;
        const bf16_t* gp0 = gate + gate_off(u.pm, 2 * u.pn, wr * 4 + wc, ln); const bf16_t* gp1 = gate + gate_off(u.pm, 2 * u.pn + 1, wr * 4 + wc, ln);
#pragma unroll
        for (int ai = 0; ai < 2; ++ai)
#pragma unroll
            for (int m = 0; m < 4; ++m) { gb[ai][m][0] = *(const u32x4*)(gp0 + (8 + ai * 4 + m) * 512); gb[ai][m][1] = *(const u32x4*)(gp1 + (8 + ai * 4 + m) * 512); }
#pragma unroll
        for (int ai = 0; ai < 2; ++ai)
#pragma unroll
            for (int m = 0; m < 4; ++m) { bf16_t* op = U + (size_t)(row0 + ai * HALF + m * 16) * UP + col0;
#pragma unroll
                for (int bj = 0; bj < 2; ++bj) { const u32x4 b = gb[ai][m][bj]; const f32x4 v0 = acc[ai][bj][m][0], v1 = acc[ai][bj][m][1];
                    u32x4 w; w.x = cvt_pk_bf16(v0[0] * bf_lo(b.x), v0[1] * bf_hi(b.x)); w.y = cvt_pk_bf16(v0[2] * bf_lo(b.y), v0[3] * bf_hi(b.y));
                    w.z = cvt_pk_bf16(v1[0] * bf_lo(b.z), v1[1] * bf_hi(b.z)); w.w = cvt_pk_bf16(v1[2] * bf_lo(b.w), v1[3] * bf_hi(b.w));
                    *(u32x4*)(op + bj * HALF) = w; } }
    }
};
struct EpiWo {
    static constexpr bool PERM = false, AFTER_DRAIN = false, HAS_MID = false;
    const float* x; const float* mod; float* out; float* rowsq;
    __device__ __forceinline__ void operator()(const f32x4 (&acc)[2][2][4][2], const Unit& u, int wr, int wc, int fr, int fq) const {
        const int b = u.pm >> 5; const float* ga1 = mod + (size_t)b * 12288 + 4096;
        int row0 = u.pm * BM + wr * 64 + fr, col0 = u.pn * BM + wc * 32 + 4 * fq; asm volatile("" : "+v"(row0), "+v"(col0));
        f32x4 gv[2][2];
#pragma unroll
        for (int bj = 0; bj < 2; ++bj)
#pragma unroll
            for (int n = 0; n < 2; ++n) gv[bj][n] = *(const f32x4*)(ga1 + col0 + bj * HALF + n * 16);
#pragma unroll
        for (int ai = 0; ai < 2; ++ai) { f32x4 xv[4][2][2];
#pragma unroll
            for (int m = 0; m < 4; ++m) { const size_t off = (size_t)(row0 + ai * HALF + m * 16) * DM + col0;
#pragma unroll
                for (int bj = 0; bj < 2; ++bj)
#pragma unroll
                    for (int n = 0; n < 2; ++n) xv[m][bj][n] = *(const f32x4*)(x + off + bj * HALF + n * 16); }
#pragma unroll
            for (int m = 0; m < 4; ++m) { const int row = row0 + ai * HALF + m * 16; const size_t off = (size_t)row * DM + col0; float ss = 0.f;
#pragma unroll
                for (int bj = 0; bj < 2; ++bj)
#pragma unroll
                    for (int n = 0; n < 2; ++n) { const f32x4 o = xv[m][bj][n] + gv[bj][n] * acc[ai][bj][m][n];
                        *(f32x4*)(out + off + bj * HALF + n * 16) = o; ss += (o[0] * o[0] + o[1] * o[1]) + (o[2] * o[2] + o[3] * o[3]); }
                ss += __shfl_xor(ss, 16); ss += __shfl_xor(ss, 32);
                if (fq == 0) rowsq[(size_t)row * 32 + u.pn * 4 + wc] = ss; }
            asm volatile("" ::: "memory"); }
    }
};
struct EpiWoDrain {
    static constexpr bool PERM = false, AFTER_DRAIN = true, HAS_MID = false;
    const float* x; const float* mod; float* out; float* rowsq;
    __device__ __forceinline__ void fused(f32x4 (&acc)[2][2][4][2], const Unit& u, int, int, int, int, PG8_LAS unsigned char* lds, int, int) const {
        int t2 = threadIdx.x; asm volatile("" : "+v"(t2));
        const int lane = t2 & 63, fr = lane & 15, fq = lane >> 4, wid = __builtin_amdgcn_readfirstlane(t2 >> 6), wr = wid >> 2, wc = wid & 3;
        const int b = u.pm >> 5; const float* ga1 = mod + (size_t)b * 12288 + 4096;
        const int colg = u.pn * BM;
        constexpr int TS = 1040;
#define EWD_BAR() do { asm volatile("s_waitcnt lgkmcnt(0)" ::: "memory"); __builtin_amdgcn_s_barrier(); asm volatile("" ::: "memory"); } while (0)
#pragma unroll
        for (int ai = 0; ai < 2; ++ai)
#pragma unroll
            for (int wq = 0; wq < 2; ++wq) { const int rbase = u.pm * BM + ai * HALF + wq * 64;
#pragma unroll
                for (int i4 = 0; i4 < 8; i4 += 4) { f32x4 xin[4];
#pragma unroll
                    for (int i = 0; i < 4; ++i) xin[i] = *(const f32x4*)(x + (size_t)(rbase + 8 * wid + i4 + i) * DM + colg + 4 * lane);
#pragma unroll
                    for (int i = 0; i < 4; ++i) *(PG8_LAS f32x4*)(lds + (8 * wid + i4 + i) * TS + lane * 16) = xin[i]; }
                EWD_BAR();
                if (wr == wq) {
                    f32x4 gv[2][2];
#pragma unroll
                    for (int bj = 0; bj < 2; ++bj)
#pragma unroll
                        for (int n = 0; n < 2; ++n) gv[bj][n] = *(const f32x4*)(ga1 + colg + bj * HALF + wc * 32 + n * 16 + 4 * fq);
#pragma unroll
                    for (int m = 0; m < 4; ++m) { const int rq = 16 * m + fr; float ss = 0.f;
#pragma unroll
                        for (int bj = 0; bj < 2; ++bj)
#pragma unroll
                            for (int n = 0; n < 2; ++n) { PG8_LAS f32x4* p = (PG8_LAS f32x4*)(lds + rq * TS + (bj * HALF + wc * 32 + n * 16 + 4 * fq) * 4);
                                const f32x4 o = *p + gv[bj][n] * acc[ai][bj][m][n]; *p = o; ss += (o[0] * o[0] + o[1] * o[1]) + (o[2] * o[2] + o[3] * o[3]); }
                        ss += __shfl_xor(ss, 16); ss += __shfl_xor(ss, 32);
                        if (fq == 0) rowsq[(size_t)(rbase + rq) * 32 + u.pn * 4 + wc] = ss; }
                }
                EWD_BAR();
#pragma unroll
                for (int i = 0; i < 8; ++i) { const f32x4 v = *(const PG8_LAS f32x4*)(lds + (8 * wid + i) * TS + lane * 16); *(f32x4*)(out + (size_t)(rbase + 8 * wid + i) * DM + colg + 4 * lane) = v; }
                EWD_BAR(); }
#undef EWD_BAR
    }
};
struct EpiSwiglu {
    static constexpr bool PERM = true, AFTER_DRAIN = false, HAS_MID = false;
    bf16_t* act;
    __device__ __forceinline__ void operator()(const f32x4 (&acc)[2][2][4][2], const Unit& u, int wr, int wc, int fr, int fq) const {
        const int row0 = u.pm * BM + wr * 64 + fr, col0 = u.pn * HALF + wc * 32 + 8 * fq;
#pragma unroll
        for (int ai = 0; ai < 2; ++ai)
#pragma unroll
            for (int m = 0; m < 4; ++m) { bf16_t* op = act + (size_t)(row0 + ai * HALF + m * 16) * FF + col0; float v[8];
#pragma unroll
                for (int n = 0; n < 2; ++n)
#pragma unroll
                    for (int e = 0; e < 4; ++e) { const float a = acc[ai][0][m][n][e], uu = acc[ai][1][m][n][e]; v[n * 4 + e] = a * sigmoidf_(a) * uu; }
                u32x4 w; w.x = cvt_pk_bf16(v[0], v[1]); w.y = cvt_pk_bf16(v[2], v[3]); w.z = cvt_pk_bf16(v[4], v[5]); w.w = cvt_pk_bf16(v[6], v[7]);
                *(u32x4*)op = w; }
    }
};
struct EpiDown {
    static constexpr bool PERM = true, AFTER_DRAIN = false, HAS_MID = false;
    const float* gsel; const float* mod; bf16_t* ym;
    __device__ __forceinline__ void operator()(const f32x4 (&acc)[2][2][4][2], const Unit& u, int wr, int wc, int fr, int fq) const {
        const int b = u.pm >> 6; const float* ga2 = mod + (size_t)b * 12288 + 10240;
        const int row0 = u.pm * BM + wr * 64 + fr, col0 = u.pn * BM + wc * 32 + 8 * fq;
        f32x4 gv[2][2];
#pragma unroll
        for (int bj = 0; bj < 2; ++bj)
#pragma unroll
            for (int n = 0; n < 2; ++n) gv[bj][n] = *(const f32x4*)(ga2 + col0 + bj * HALF + n * 4);
#pragma unroll
        for (int ai = 0; ai < 2; ++ai)
#pragma unroll
            for (int m = 0; m < 4; ++m) { const int row = row0 + ai * HALF + m * 16; const float gs = gsel[row]; bf16_t* op = ym + (size_t)row * DM + col0;
#pragma unroll
                for (int bj = 0; bj < 2; ++bj) { const f32x4 v0 = acc[ai][bj][m][0] * gv[bj][0] * gs, v1 = acc[ai][bj][m][1] * gv[bj][1] * gs;
                    u32x4 w; w.x = cvt_pk_bf16(v0[0], v0[1]); w.y = cvt_pk_bf16(v0[2], v0[3]); w.z = cvt_pk_bf16(v1[0], v1[1]); w.w = cvt_pk_bf16(v1[2], v1[3]);
                    *(u32x4*)(op + bj * HALF) = w; } }
    }
};

template <class Epi, class Sched, bool ALIGN_EPI = false, bool SP2 = false>
__device__ __forceinline__ void gemm_phase(PG8_LAS unsigned char* lds, const Gemm g, const Sched& S, const Epi& E) {
    const int tid = threadIdx.x, wid = __builtin_amdgcn_readfirstlane(tid >> 6), lane = tid & 63, wr = wid >> 2, wc = wid & 3, fr = lane & 15, fq = lane >> 4;
    const int K = g.K, nt = K / BK, lda = g.lda ? g.lda : K;
    unsigned voffA[2], voffB[2];
#pragma unroll
    for (int i = 0; i < 2; ++i) { int R, C; stage_rc(tid * 16 + i * 8192, R, C); const int Rb = Epi::PERM ? ((R & ~31) + perm32(R & 31)) : R;
        voffA[i] = (unsigned)(R * lda + C) * 2u; voffB[i] = (unsigned)(tid * 16 + i * 8192); (void)Rb; }
    unsigned gc0[2] = {0u, 0u}, gc1[2] = {0u, 0u}, gn0[2] = {0u, 0u}, gn1[2] = {0u, 0u};
#define PG8_GLOOK(u, o0, o1) do { _Pragma("unroll") for (int _i = 0; _i < 2; ++_i) { int R_, C_; stage_rc(tid * 16 + _i * 8192, R_, C_); \
        o0[_i] = (unsigned)S.rowmap[(u).pm * BM + R_] * (unsigned)(K * 2) + (unsigned)(C_ * 2); o1[_i] = (unsigned)S.rowmap[(u).pm * BM + HALF + R_] * (unsigned)(K * 2) + (unsigned)(C_ * 2); } } while (0)
    const size_t kstep = (size_t)(BK * 2);
    const size_t hstep = (size_t)HALF * lda * 2;
    const size_t tstep = 2 * hstep;
    const size_t kstepB = 32768, hstepB = 16384, tstepB = (size_t)nt * 32768;
    const unsigned ldsw = (unsigned)wid * 1024u;
    const int aoff = lds_byte(wr * 64 + fr, fq * 8), boff = lds_byte(wc * 32 + fr, fq * 8);
#define PG8_SA(b, h) (((b) * 2 + (h)) * HTB)
#define PG8_SB(b, h) ((4 + (b) * 2 + (h)) * HTB)
#define PG8_STAGE(bufoff, gbase, voff) do { _Pragma("unroll") for (int _i = 0; _i < 2; ++_i) \
        __builtin_amdgcn_global_load_lds((const unsigned*)((const char*)(gbase) + (voff)[_i]), (PG8_LAS unsigned*)(lds + (bufoff) + ldsw + _i * 8192), 16, 0, 0); } while (0)
#define PG8_STAGE_AC(bufoff, kptr, half) do { if constexpr (Sched::GATHER) { if constexpr ((half) == 0) PG8_STAGE(bufoff, kptr, gc0); else PG8_STAGE(bufoff, kptr, gc1); } else { PG8_STAGE(bufoff, (kptr) + (half) * hstep, voffA); } } while (0)
#define PG8_STAGE_AS(bufoff, kptr, half) do { if constexpr (Sched::GATHER) { if constexpr ((half) == 0) PG8_STAGE(bufoff, kptr, gs0); else PG8_STAGE(bufoff, kptr, gs1); } else { PG8_STAGE(bufoff, (kptr) + (half) * hstep, voffA); } } while (0)
#define PG8_LDA(dst, b, h) do { _Pragma("unroll") for (int m = 0; m < 4; ++m) _Pragma("unroll") for (int k = 0; k < 2; ++k) dst[m][k] = *(const PG8_LAS bf16x8*)(lds + PG8_SA(b, h) + aoff + m * 2048 + k * 1024); } while (0)
#define PG8_LDB(dst, b, h) do { _Pragma("unroll") for (int n = 0; n < 2; ++n) _Pragma("unroll") for (int k = 0; k < 2; ++k) dst[n][k] = *(const PG8_LAS bf16x8*)(lds + PG8_SB(b, h) + boff + n * 2048 + k * 1024); } while (0)
#define PG8_MMA(ai, bj, At, Bt) do { __builtin_amdgcn_s_setprio(1); _Pragma("unroll") for (int m = 0; m < 4; ++m) _Pragma("unroll") for (int n = 0; n < 2; ++n) _Pragma("unroll") for (int k = 0; k < 2; ++k) \
        acc[ai][bj][m][n] = __builtin_amdgcn_mfma_f32_16x16x32_bf16(Bt[n][k], At[m][k], acc[ai][bj][m][n], 0, 0, 0); __builtin_amdgcn_s_setprio(0); } while (0)
#define PG8_WAIT_V(n) asm volatile("s_waitcnt vmcnt(" #n ")" ::: "memory")
#define PG8_WAIT_L(n) asm volatile("s_waitcnt lgkmcnt(" #n ")" ::: "memory")
#define PG8_BAR __builtin_amdgcn_s_barrier()
#define PG8_SCHED __builtin_amdgcn_sched_barrier(0)
    Unit cur, nxt; int ui = 0;
    if (!S.next(0, cur)) return;
    f32x4 acc[2][2][4][2];
#pragma unroll
    for (int a = 0; a < 2; ++a)
#pragma unroll
        for (int b = 0; b < 2; ++b)
#pragma unroll
            for (int m = 0; m < 4; ++m)
#pragma unroll
                for (int n = 0; n < 2; ++n) acc[a][b][m][n] = (f32x4){0.f, 0.f, 0.f, 0.f};
    bf16x8 At[4][2], B0[2][2], B1[2][2];
    const char* cA = (const char*)g.A + (Sched::GATHER ? (size_t)0 : (size_t)cur.pm * tstep); const char* cB = (const char*)g.Bt + S.bofs(cur) + (size_t)cur.pn * tstepB;
    if constexpr (Sched::GATHER) { static_assert(!Sched::GATHER || SP2, "GATHER is wired into the SP2 loop only"); PG8_GLOOK(cur, gc0, gc1); }
    S.a_ready(cur);
    if constexpr (SP2) {
        PG8_STAGE(PG8_SB(0, 0), cB, voffB); PG8_STAGE(PG8_SB(0, 1), cB + hstepB, voffB); PG8_STAGE_AC(PG8_SA(0, 0), cA, 0); PG8_STAGE_AC(PG8_SA(0, 1), cA, 1);
        if (wr == 1) PG8_BAR;
        PG8_WAIT_V(2); PG8_BAR;
        PG8_STAGE(PG8_SB(1, 0), cB + kstepB, voffB); PG8_STAGE_AC(PG8_SA(1, 0), cA + kstep, 0); PG8_STAGE(PG8_SB(1, 1), cB + hstepB + kstepB, voffB);
        PG8_WAIT_V(6); PG8_BAR;
    } else {
        PG8_STAGE(PG8_SB(0, 0), cB, voffB); PG8_STAGE(PG8_SA(0, 0), cA, voffA); PG8_STAGE(PG8_SB(0, 1), cB + hstepB, voffB); PG8_STAGE(PG8_SA(0, 1), cA + hstep, voffA);
        if (wr == 1) PG8_BAR;
        PG8_WAIT_V(4); PG8_BAR;
        PG8_STAGE(PG8_SB(1, 0), cB + kstepB, voffB); PG8_STAGE(PG8_SA(1, 0), cA + kstep, voffA); PG8_STAGE(PG8_SB(1, 1), cB + hstepB + kstepB, voffB);
        PG8_WAIT_V(6); PG8_BAR;
    }
    for (;;) {
        const bool has_next = S.next(ui + 1, nxt);
        const char* nA = (has_next && !Sched::GATHER) ? (const char*)g.A + (size_t)nxt.pm * tstep : cA;
        if constexpr (Sched::GATHER) { if (has_next) PG8_GLOOK(nxt, gn0, gn1); else { gn0[0] = gc0[0]; gn0[1] = gc0[1]; gn1[0] = gc1[0]; gn1[1] = gc1[1]; } } const char* nB = has_next ? (const char*)g.Bt + S.bofs(nxt) + (size_t)nxt.pn * tstepB : cB;
        for (int t = 0; t < nt; t += 2) {
            const bool last = (t == nt - 2);
            if constexpr (Epi::HAS_MID) { if (t == (nt >> 1)) E.mid(acc, cur, wr, wc, fr, fq); }
            const char* a1 = cA + (size_t)(t + 1) * kstep;
            const char* a2 = last ? nA : cA + (size_t)(t + 2) * kstep; const char* b2 = last ? nB : cB + (size_t)(t + 2) * kstepB;
            const char* a3 = a2 + kstep; const char* b3 = b2 + kstepB;
            unsigned gs0[2], gs1[2]; if constexpr (Sched::GATHER) { gs0[0] = last ? gn0[0] : gc0[0]; gs0[1] = last ? gn0[1] : gc0[1]; gs1[0] = last ? gn1[0] : gc1[0]; gs1[1] = last ? gn1[1] : gc1[1]; } else { gs0[0] = gs0[1] = gs1[0] = gs1[1] = 0u; }
            if (last && has_next) S.a_ready(nxt);
            if constexpr (SP2) {
            PG8_LDB(B0, 0, 0); PG8_LDB(B1, 0, 1); PG8_SCHED; PG8_LDA(At, 0, 0); PG8_STAGE_AC(PG8_SA(1, 1), a1, 1);
            PG8_WAIT_V(8); PG8_WAIT_L(0); PG8_BAR; PG8_MMA(0, 0, At, B0); PG8_MMA(0, 1, At, B1); PG8_BAR; PG8_SCHED;
            PG8_LDA(At, 0, 1); PG8_STAGE(PG8_SB(0, 0), b2, voffB); PG8_STAGE(PG8_SB(0, 1), b2 + hstepB, voffB); PG8_STAGE_AS(PG8_SA(0, 0), a2, 0);
            PG8_WAIT_V(8); PG8_WAIT_L(0); PG8_BAR; PG8_MMA(1, 0, At, B0); PG8_MMA(1, 1, At, B1); PG8_BAR; PG8_SCHED;
            PG8_LDB(B0, 1, 0); PG8_LDB(B1, 1, 1); PG8_SCHED; PG8_LDA(At, 1, 0); PG8_STAGE_AS(PG8_SA(0, 1), a2, 1);
            PG8_WAIT_V(8); PG8_WAIT_L(0); PG8_BAR; PG8_MMA(0, 0, At, B0); PG8_MMA(0, 1, At, B1); PG8_BAR; PG8_SCHED;
            PG8_LDA(At, 1, 1); PG8_STAGE(PG8_SB(1, 0), b3, voffB); PG8_STAGE(PG8_SB(1, 1), b3 + hstepB, voffB); PG8_STAGE_AS(PG8_SA(1, 0), a3, 0);
            PG8_WAIT_V(8); PG8_WAIT_L(0); PG8_BAR; PG8_MMA(1, 0, At, B0); PG8_MMA(1, 1, At, B1); PG8_BAR; PG8_SCHED;
            } else {
            PG8_LDB(B0, 0, 0); PG8_SCHED; PG8_LDA(At, 0, 0); PG8_STAGE(PG8_SA(1, 1), a1 + hstep, voffA);
            PG8_WAIT_L(8); PG8_BAR; PG8_WAIT_L(0); PG8_MMA(0, 0, At, B0); PG8_BAR; PG8_SCHED;
            PG8_LDB(B1, 0, 1); PG8_STAGE(PG8_SB(0, 0), b2, voffB);
            PG8_BAR; PG8_WAIT_L(0); PG8_MMA(0, 1, At, B1); PG8_BAR;
            PG8_LDA(At, 0, 1); PG8_STAGE(PG8_SA(0, 0), a2, voffA);
            PG8_BAR; PG8_WAIT_L(0); PG8_MMA(1, 0, At, B0); PG8_BAR; PG8_SCHED;
            PG8_STAGE(PG8_SB(0, 1), b2 + hstepB, voffB);
            PG8_WAIT_V(6); PG8_BAR; PG8_MMA(1, 1, At, B1); PG8_BAR;
            PG8_LDB(B0, 1, 0); PG8_SCHED; PG8_LDA(At, 1, 0); PG8_STAGE(PG8_SA(0, 1), a2 + hstep, voffA);
            PG8_WAIT_L(8); PG8_BAR; PG8_WAIT_L(0); PG8_MMA(0, 0, At, B0); PG8_BAR; PG8_SCHED;
            PG8_LDB(B1, 1, 1); PG8_STAGE(PG8_SB(1, 0), b3, voffB);
            PG8_BAR; PG8_WAIT_L(0); PG8_MMA(0, 1, At, B1); PG8_BAR;
            PG8_LDA(At, 1, 1); PG8_STAGE(PG8_SA(1, 0), a3, voffA);
            PG8_BAR; PG8_WAIT_L(0); PG8_MMA(1, 0, At, B0); PG8_BAR; PG8_SCHED;
            PG8_STAGE(PG8_SB(1, 1), b3 + hstepB, voffB);
            PG8_WAIT_V(6); PG8_BAR; PG8_MMA(1, 1, At, B1); PG8_BAR;
            }
        }
        if constexpr (ALIGN_EPI) { if (wr == 0) PG8_BAR; }
        if constexpr (!Epi::AFTER_DRAIN) { E(acc, cur, wr, wc, fr, fq); S.done(cur); }
        if (!has_next) break;
#pragma unroll
        for (int a = 0; a < 2; ++a)
#pragma unroll
            for (int b = 0; b < 2; ++b)
#pragma unroll
                for (int m = 0; m < 4; ++m)
#pragma unroll
                    for (int n = 0; n < 2; ++n) acc[a][b][m][n] = (f32x4){0.f, 0.f, 0.f, 0.f};
        cur = nxt; cA = nA; cB = nB; ++ui;
        if constexpr (Sched::GATHER) { gc0[0] = gn0[0]; gc0[1] = gn0[1]; gc1[0] = gn1[0]; gc1[1] = gn1[1]; }
        if constexpr (ALIGN_EPI) { if (wr == 1) PG8_BAR; }
    }
    PG8_WAIT_V(0);
    if constexpr (!ALIGN_EPI) { if (wr == 0) PG8_BAR; }
    PG8_BAR;
    if constexpr (Epi::AFTER_DRAIN) { E.fused(acc, cur, wr, wc, fr, fq, lds, wid, lane); S.done(cur); }
#undef PG8_SA
#undef PG8_SB
#undef PG8_STAGE
#undef PG8_STAGE_AC
#undef PG8_STAGE_AS
#undef PG8_GLOOK
#undef PG8_LDA
#undef PG8_LDB
#undef PG8_MMA
#undef PG8_WAIT_V
#undef PG8_WAIT_L
#undef PG8_BAR
#undef PG8_SCHED
}
}

namespace att {
using bf16x8 = __attribute__((ext_vector_type(8))) short;
using s16x4  = __attribute__((ext_vector_type(4))) short;
using f32x16 = __attribute__((ext_vector_type(16))) float;
using u32x4  = __attribute__((ext_vector_type(4))) unsigned;
typedef unsigned short bf16_t;
constexpr int LDR = 1024;
constexpr int SHM_V = 64 * 128 * 2, SHM_K = 64 * 128 * 2;
constexpr int SLOT = SHM_V + SHM_K, NSLOT = 4;
constexpr int LDS_WS = 131072 + 1024;
constexpr int LDS_BIAS = LDS_WS + 8 * 64 * 4;
constexpr int LDS_ATT_BYTES = LDS_BIAS + 2048;
#define KSWZ(row, colB) ((row) * 256 + ((colB) ^ (((row) & 15) << 4)))
#define SBAR() __builtin_amdgcn_sched_barrier(0)
__device__ __forceinline__ int crow(int r, int hi) { return (r & 3) + 8 * (r >> 2) + 4 * hi; }
typedef float f32x2_cv __attribute__((ext_vector_type(2))); typedef __bf16 bf16x2_cv __attribute__((ext_vector_type(2)));
__device__ __forceinline__ unsigned cvtpk(float lo, float hi) { const f32x2_cv v = {lo, hi}; const bf16x2_cv b = __builtin_convertvector(v, bf16x2_cv); return __builtin_bit_cast(unsigned, b); }
__device__ __forceinline__ int v_st(int k, int c) { const int kk = (k & ~0xC) | ((k & 4) << 1) | ((k & 8) >> 1); return ((kk >> 3) * 4 + (c >> 5)) * 512 + ((kk & 7) * 32 + (c & 31)) * 2; }
__device__ __forceinline__ int v_rd_base(int lane) { return ((lane & 3) << 3) | (((lane >> 2) & 3) << 6) | (((lane >> 4) & 1) << 5) | (((lane >> 5) & 1) << 8); }
constexpr int v_rd_off(int d0, int ks, int half) { return d0 * 512 + ks * 4096 + half * 2048; }
template <int OFF> __device__ __forceinline__ s16x4 tr_read(int vb) { s16x4 r; asm volatile("ds_read_b64_tr_b16 %0, %1 offset:%2" : "=&v"(r) : "v"(vb), "i"(OFF) : "memory"); return r; }
template <int D0> __device__ __forceinline__ void pv_one(f32x16& od, int vb, bf16x8 pa0, bf16x8 pa1, bf16x8 pa2, bf16x8 pa3) {
    const s16x4 l0 = tr_read<v_rd_off(D0, 0, 0)>(vb), h0 = tr_read<v_rd_off(D0, 0, 1)>(vb), l1 = tr_read<v_rd_off(D0, 1, 0)>(vb), h1 = tr_read<v_rd_off(D0, 1, 1)>(vb);
    const s16x4 l2 = tr_read<v_rd_off(D0, 2, 0)>(vb), h2 = tr_read<v_rd_off(D0, 2, 1)>(vb), l3 = tr_read<v_rd_off(D0, 3, 0)>(vb), h3 = tr_read<v_rd_off(D0, 3, 1)>(vb);
    asm volatile("s_waitcnt lgkmcnt(0)" ::: "memory"); SBAR();
#define PK(L, H) (bf16x8){L[0], L[1], L[2], L[3], H[0], H[1], H[2], H[3]}
    od = __builtin_amdgcn_mfma_f32_32x32x16_bf16(pa0, PK(l0, h0), od, 0, 0, 0);
    od = __builtin_amdgcn_mfma_f32_32x32x16_bf16(pa1, PK(l1, h1), od, 0, 0, 0);
    od = __builtin_amdgcn_mfma_f32_32x32x16_bf16(pa2, PK(l2, h2), od, 0, 0, 0);
    od = __builtin_amdgcn_mfma_f32_32x32x16_bf16(pa3, PK(l3, h3), od, 0, 0, 0);
#undef PK
}
__device__ __forceinline__ void pv_d0(f32x16* o, int vb, bf16x8 pa0, bf16x8 pa1, bf16x8 pa2, bf16x8 pa3) {
#define RD8(D0, L0, H0, L1, H1, L2, H2, L3, H3) const s16x4 L0 = tr_read<v_rd_off(D0, 0, 0)>(vb), H0 = tr_read<v_rd_off(D0, 0, 1)>(vb), L1 = tr_read<v_rd_off(D0, 1, 0)>(vb), H1 = tr_read<v_rd_off(D0, 1, 1)>(vb), \
    L2 = tr_read<v_rd_off(D0, 2, 0)>(vb), H2 = tr_read<v_rd_off(D0, 2, 1)>(vb), L3 = tr_read<v_rd_off(D0, 3, 0)>(vb), H3 = tr_read<v_rd_off(D0, 3, 1)>(vb)
#define PK(L, H) (bf16x8){L[0], L[1], L[2], L[3], H[0], H[1], H[2], H[3]}
#define MM4(OD, L0, H0, L1, H1, L2, H2, L3, H3) do { OD = __builtin_amdgcn_mfma_f32_32x32x16_bf16(pa0, PK(L0, H0), OD, 0, 0, 0); OD = __builtin_amdgcn_mfma_f32_32x32x16_bf16(pa1, PK(L1, H1), OD, 0, 0, 0); \
    OD = __builtin_amdgcn_mfma_f32_32x32x16_bf16(pa2, PK(L2, H2), OD, 0, 0, 0); OD = __builtin_amdgcn_mfma_f32_32x32x16_bf16(pa3, PK(L3, H3), OD, 0, 0, 0); } while (0)
    RD8(0, a0, b0, a1, b1, a2, b2, a3, b3);
    RD8(1, c0, d0, c1, d1, c2, d2, c3, d3);
    asm volatile("s_waitcnt lgkmcnt(8)" ::: "memory"); SBAR(); MM4(o[0], a0, b0, a1, b1, a2, b2, a3, b3); SBAR();
    RD8(2, e0, f0, e1, f1, e2, f2, e3, f3);
    asm volatile("s_waitcnt lgkmcnt(8)" ::: "memory"); SBAR(); MM4(o[1], c0, d0, c1, d1, c2, d2, c3, d3); SBAR();
    RD8(3, g0, h0, g1, h1, g2, h2, g3, h3);
    asm volatile("s_waitcnt lgkmcnt(8)" ::: "memory"); SBAR(); MM4(o[2], e0, f0, e1, f1, e2, f2, e3, f3); SBAR();
    asm volatile("s_waitcnt lgkmcnt(0)" ::: "memory"); SBAR(); MM4(o[3], g0, h0, g1, h1, g2, h2, g3, h3);
#undef RD8
#undef PK
#undef MM4
}
template <int D0, int KB> __device__ __forceinline__ void pvb_one(f32x16& od, int vb, bf16x8 pa, bf16x8 pb) {
    const s16x4 l0 = tr_read<v_rd_off(D0, 2 * KB, 0)>(vb), h0 = tr_read<v_rd_off(D0, 2 * KB, 1)>(vb), l1 = tr_read<v_rd_off(D0, 2 * KB + 1, 0)>(vb), h1 = tr_read<v_rd_off(D0, 2 * KB + 1, 1)>(vb);
    asm volatile("s_waitcnt lgkmcnt(0)" ::: "memory"); SBAR();
#define PK(L, H) (bf16x8){L[0], L[1], L[2], L[3], H[0], H[1], H[2], H[3]}
    od = __builtin_amdgcn_mfma_f32_32x32x16_bf16(pa, PK(l0, h0), od, 0, 0, 0);
    od = __builtin_amdgcn_mfma_f32_32x32x16_bf16(pb, PK(l1, h1), od, 0, 0, 0);
#undef PK
}
template <int D0, int ND> __device__ __forceinline__ void qkt(f32x16& p0, f32x16& p1, const char* Ks, const bf16x8* qr, int r32, int hi) {
    p0 = f32x16{}; p1 = f32x16{};
#pragma unroll
    for (int d0 = D0; d0 < D0 + ND; ++d0) { const int cb = (d0 * 16 + hi * 8) * 2;
        const bf16x8 b0 = *reinterpret_cast<const bf16x8*>(Ks + KSWZ(r32, cb));
        const bf16x8 b1 = *reinterpret_cast<const bf16x8*>(Ks + KSWZ(32 + r32, cb));
        p0 = __builtin_amdgcn_mfma_f32_32x32x16_bf16(b0, qr[d0], p0, 0, 0, 0);
        p1 = __builtin_amdgcn_mfma_f32_32x32x16_bf16(b1, qr[d0], p1, 0, 0, 0); }
}
__device__ __forceinline__ void pack_p(const f32x16& p0, const f32x16& p1, bf16x8& pa0, bf16x8& pa1, bf16x8& pa2, bf16x8& pa3) {
#define PK4(P, BASE, OUT) do { unsigned a0 = cvtpk(P[BASE + 0], P[BASE + 1]), a1 = cvtpk(P[BASE + 2], P[BASE + 3]);   \
    unsigned b0 = cvtpk(P[BASE + 4], P[BASE + 5]), b1 = cvtpk(P[BASE + 6], P[BASE + 7]);                              \
    auto r0 = __builtin_amdgcn_permlane32_swap(a0, b0, false, false); auto r1 = __builtin_amdgcn_permlane32_swap(a1, b1, false, false); \
    u32x4 w = {r0[0], r1[0], r0[1], r1[1]}; OUT = *reinterpret_cast<bf16x8*>(&w); } while (0)
    PK4(p0, 0, pa0); PK4(p0, 8, pa1); PK4(p1, 0, pa2); PK4(p1, 8, pa3);
#undef PK4
}
__device__ __forceinline__ float half_sum(float v) { auto rr = __builtin_amdgcn_permlane32_swap(__float_as_uint(v), __float_as_uint(v), false, false); return __uint_as_float(rr[0]) + __uint_as_float(rr[1]); }

struct Stager {
    int sr, sc, vst0, vst1; bf16x8 vs0, vs1, ks0, ks1;
    __device__ __forceinline__ void init(int tid) { sr = tid >> 4; sc = (tid & 15) * 8; vst0 = v_st(sr, sc); vst1 = v_st(32 + sr, sc); }
    __device__ __forceinline__ void load(const bf16_t* Kt, const bf16_t* Vt) {
        vs0 = *reinterpret_cast<const bf16x8*>(Vt + (size_t)sr * LDR + sc); vs1 = *reinterpret_cast<const bf16x8*>(Vt + (size_t)(32 + sr) * LDR + sc);
        ks0 = *reinterpret_cast<const bf16x8*>(Kt + (size_t)sr * LDR + sc); ks1 = *reinterpret_cast<const bf16x8*>(Kt + (size_t)(32 + sr) * LDR + sc);
    }
    __device__ __forceinline__ void write(char* lds, int b) {
        *(bf16x8*)(lds + b * SHM_V + vst0) = vs0; *(bf16x8*)(lds + b * SHM_V + vst1) = vs1; const int kc = sc * 2;
        *(bf16x8*)(lds + 2 * SHM_V + b * SHM_K + KSWZ(sr, kc)) = ks0; *(bf16x8*)(lds + 2 * SHM_V + b * SHM_K + KSWZ(32 + sr, kc)) = ks1;
    }
};

typedef float f32x4v __attribute__((ext_vector_type(4)));
#define MFMA16(a, b, c) __builtin_amdgcn_mfma_f32_16x16x32_bf16(a, b, c, 0, 0, 0)
template <int DT, int KB> __device__ __forceinline__ void pvb16_pair(f32x4v (&o)[2][8], int vb, bf16x8 pa, bf16x8 pb) {
    const s16x4 l0 = tr_read<((2 * KB) * 8 + DT) * 512>(vb), h0 = tr_read<((2 * KB + 1) * 8 + DT) * 512>(vb), l1 = tr_read<((2 * KB) * 8 + DT + 1) * 512>(vb), h1 = tr_read<((2 * KB + 1) * 8 + DT + 1) * 512>(vb);
    asm volatile("s_waitcnt lgkmcnt(0)" ::: "memory"); SBAR();
#define PK(L, H) (bf16x8){L[0], L[1], L[2], L[3], H[0], H[1], H[2], H[3]}
    o[0][DT] = MFMA16(pa, PK(l0, h0), o[0][DT]); o[1][DT] = MFMA16(pb, PK(l0, h0), o[1][DT]);
    o[0][DT + 1] = MFMA16(pa, PK(l1, h1), o[0][DT + 1]); o[1][DT + 1] = MFMA16(pb, PK(l1, h1), o[1][DT + 1]);
#undef PK
}
__device__ __forceinline__ void diff_epilogue(f32x4v (&o)[2][8], float l0, float l1, int b, int h, int qb, bf16_t* Y, float lam, const float* subln, char* lds);
__device__ __forceinline__ void diff_unit(int b, int h, int qb, const bf16_t* QA, const bf16_t* KA, const bf16_t* VA, bf16_t* Y, float lam, const float* subln, char* lds, __attribute__((address_space(3))) unsigned char* lds3) {
    int tid = threadIdx.x; asm volatile("" : "+v"(tid));
    const int lane = tid & 63, l15 = lane & 15, g = lane >> 4; const int wid = __builtin_amdgcn_readfirstlane(tid >> 6); const int br = wid >> 2, wq = wid & 3;
    const size_t qrow0 = (size_t)b * SEQ + (size_t)qb * 128 + wq * 32;
    const bf16_t* Kc = KA + ((size_t)MTOK + (size_t)b * CTXL) * LDR + h * 128; const bf16_t* Kl = KA + ((size_t)b * SEQ) * LDR + h * 128;
    const bf16_t* Vc = VA + ((size_t)MTOK + (size_t)b * CTXL) * LDR + h * 128; const bf16_t* Vl = VA + ((size_t)b * SEQ) * LDR + h * 128;
    constexpr int NT = (CTXL + SEQ) / 64;
    bf16x8 qr[2][2];
#pragma unroll
    for (int qt = 0; qt < 2; ++qt)
#pragma unroll
        for (int ds = 0; ds < 2; ++ds) qr[qt][ds] = *reinterpret_cast<const bf16x8*>(QA + (qrow0 + 16 * qt + l15) * LDR + h * 128 + br * 64 + 32 * ds + 8 * g);
    unsigned koff[2], voff[2];
#pragma unroll
    for (int i = 0; i < 2; ++i) { const int p = 2 * wid + i;
        const int krow = 4 * p + (lane >> 4), kch = (lane & 15) ^ (krow & 15); koff[i] = (unsigned)(krow * LDR + 8 * kch) * 2u;
        const int sub = 2 * p + (lane >> 5), key = (sub >> 3) * 16 + ((lane & 31) >> 1), col = (sub & 7) * 16 + 8 * (lane & 1);
        voff[i] = (unsigned)(key * LDR + col) * 2u; }
    const int vb0 = (int)(uintptr_t)lds + (4 * g + (l15 >> 2)) * 32 + (l15 & 3) * 8;
    const int kcb = br * 128 + g * 16;
    const unsigned pw = (unsigned)wid * 2048u;
#define TILE_K(t) ((const char*)((t) < 4 ? Kc + (size_t)(t) * 64 * LDR : Kl + (size_t)((t) - 4) * 64 * LDR))
#define TILE_V(t) ((const char*)((t) < 4 ? Vc + (size_t)(t) * 64 * LDR : Vl + (size_t)((t) - 4) * 64 * LDR))
#define DMA(t, so) do { const char* kt_ = TILE_K(t); const char* vt_ = TILE_V(t); \
    _Pragma("unroll") for (int i_ = 0; i_ < 2; ++i_) { \
        __builtin_amdgcn_global_load_lds((const unsigned*)(vt_ + voff[i_]), (__attribute__((address_space(3))) unsigned*)(lds3 + (so) + pw + i_ * 1024), 16, 0, 0); \
        __builtin_amdgcn_global_load_lds((const unsigned*)(kt_ + koff[i_]), (__attribute__((address_space(3))) unsigned*)(lds3 + (so) + SHM_V + pw + i_ * 1024), 16, 0, 0); } } while (0)
#define WAITBAR(n) asm volatile("s_waitcnt vmcnt(" #n ") lgkmcnt(0)\n\ts_barrier" ::: "memory")
#define QKB(P, so, kb) do { const char* Ks_ = lds + (so) + SHM_V; P[0] = f32x4v{}; P[1] = f32x4v{}; P[2] = f32x4v{}; P[3] = f32x4v{}; \
    _Pragma("unroll") for (int ds_ = 0; ds_ < 2; ++ds_) \
    _Pragma("unroll") for (int kt_ = 0; kt_ < 2; ++kt_) { \
        const bf16x8 a_ = *reinterpret_cast<const bf16x8*>(Ks_ + (32 * (kb) + 16 * kt_ + l15) * 256 + ((kcb + 64 * ds_) ^ (l15 << 4))); \
        P[kt_ * 2] = MFMA16(a_, qr[0][ds_], P[kt_ * 2]); P[kt_ * 2 + 1] = MFMA16(a_, qr[1][ds_], P[kt_ * 2 + 1]); } } while (0)
#define PKT(P, T0, T1, OUT) do { u32x4 w_ = {cvtpk(P[T0][0], P[T0][1]), cvtpk(P[T0][2], P[T0][3]), cvtpk(P[T1][0], P[T1][1]), cvtpk(P[T1][2], P[T1][3])}; OUT = *reinterpret_cast<bf16x8*>(&w_); } while (0)
#define FINB(P) do { float p0_ = 0.f, p1_ = 0.f; _Pragma("unroll") for (int e_ = 0; e_ < 4; ++e_) { \
        P[0][e_] = __builtin_amdgcn_exp2f(P[0][e_]); P[1][e_] = __builtin_amdgcn_exp2f(P[1][e_]); P[2][e_] = __builtin_amdgcn_exp2f(P[2][e_]); P[3][e_] = __builtin_amdgcn_exp2f(P[3][e_]); \
        p0_ += P[0][e_] + P[2][e_]; p1_ += P[1][e_] + P[3][e_]; } \
    l0 += p0_; l1 += p1_; PKT(P, 0, 2, paA); PKT(P, 1, 3, paB); } while (0)
#define PVB(so, kb) do { const int vb_ = vb0 + (so); pvb16_pair<0, kb>(o, vb_, paA, paB); pvb16_pair<2, kb>(o, vb_, paA, paB); pvb16_pair<4, kb>(o, vb_, paA, paB); pvb16_pair<6, kb>(o, vb_, paA, paB); } while (0)
#define ROT() do { s_prev = s_cur; s_cur = s_nxt; s_nxt = s_nx2; s_nx2 = (s_nx2 == (NSLOT - 1) * SLOT) ? 0 : s_nx2 + SLOT; } while (0)
    f32x4v o[2][8];
#pragma unroll
    for (int qt = 0; qt < 2; ++qt)
#pragma unroll
        for (int d = 0; d < 8; ++d) o[qt][d] = f32x4v{};
    float l0 = 0.f, l1 = 0.f; f32x4v pX[4], pY[4]; bf16x8 paA, paB;
    int s_prev = 0, s_cur = 0, s_nxt = SLOT, s_nx2 = 2 * SLOT;
    DMA(0, 0); DMA(1, SLOT);
    WAITBAR(4);
    DMA(2, 2 * SLOT);
    QKB(pX, 0, 0);
    SBAR(); QKB(pY, 0, 1); FINB(pX); SBAR();
    PVB(0, 0);
    WAITBAR(4);
    ROT();
#define STEP(j, HAS2) do { \
    if (HAS2) DMA((j) + 2, s_nx2); \
    SBAR(); QKB(pX, s_cur, 0); FINB(pY); SBAR(); \
    PVB(s_prev, 1); \
    SBAR(); QKB(pY, s_cur, 1); FINB(pX); SBAR(); \
    PVB(s_cur, 0); \
    if (HAS2) WAITBAR(4); else WAITBAR(0); \
    ROT(); } while (0)
    for (int j = 1; j + 2 < NT; ++j) STEP(j, true);
    STEP(NT - 2, false);
    STEP(NT - 1, false);
    FINB(pY); SBAR();
    PVB(s_prev, 1);
#undef QKB
#undef PKT
#undef FINB
#undef PVB
#undef TILE_K
#undef TILE_V
#undef DMA
#undef ROT
#undef STEP
#undef WAITBAR
    l0 += __shfl_xor(l0, 16); l0 += __shfl_xor(l0, 32); l1 += __shfl_xor(l1, 16); l1 += __shfl_xor(l1, 32);
    diff_epilogue(o, l0, l1, b, h, qb, Y, lam, subln, lds);
}
__device__ __forceinline__ void diff_epilogue(f32x4v (&o)[2][8], float l0, float l1, int b, int h, int qb, bf16_t* Y, float lam, const float* subln, char* lds) {
    int tid = threadIdx.x; asm volatile("" : "+v"(tid));
    const int lane = tid & 63, l15 = lane & 15, g = lane >> 4; const int wid = __builtin_amdgcn_readfirstlane(tid >> 6); const int br = wid >> 2, wq = wid & 3;
    float* ws = (float*)(lds + LDS_WS) + wid * 64;
    const size_t qrow0 = (size_t)b * SEQ + (size_t)qb * 128 + wq * 32;
#define WAITBAR(n) asm volatile("s_waitcnt vmcnt(" #n ") lgkmcnt(0)\n\ts_barrier" ::: "memory")
    if (g == 0) { ws[l15] = l0; ws[16 + l15] = l1; }
    WAITBAR(0);
    float* xb = (float*)lds + wq * 4096 + lane;
    if (br == 1) {
#pragma unroll
        for (int qt = 0; qt < 2; ++qt)
#pragma unroll
            for (int i = 0; i < 4; ++i) { const float i2 = lam * __builtin_amdgcn_rcpf(ws[16 * qt + 4 * g + i]);
#pragma unroll
                for (int d = 0; d < 8; ++d) xb[((qt * 8 + d) * 4 + i) * 64] = o[qt][d][i] * i2; }
    }
    WAITBAR(0);
    if (br == 0) {
        float sg[8];
#pragma unroll
        for (int d = 0; d < 8; ++d) sg[d] = subln[d * 16 + l15] * 0.8f;
#pragma unroll
        for (int qt = 0; qt < 2; ++qt)
#pragma unroll
            for (int i = 0; i < 4; ++i) { const int orow = 16 * qt + 4 * g + i; const float i1 = __builtin_amdgcn_rcpf(ws[orow]);
                float y[8], ss = 0.f;
#pragma unroll
                for (int d = 0; d < 8; ++d) { y[d] = o[qt][d][i] * i1 - xb[((qt * 8 + d) * 4 + i) * 64]; ss += y[d] * y[d]; }
                ss += __shfl_xor(ss, 1); ss += __shfl_xor(ss, 2); ss += __shfl_xor(ss, 4); ss += __shfl_xor(ss, 8);
                const float rs = __builtin_amdgcn_rsqf(ss * (1.0f / 128.0f) + EPS);
                bf16_t* yp = Y + (qrow0 + orow) * DM + h * 128 + l15;
#pragma unroll
                for (int d = 0; d < 8; ++d) { const unsigned w = cvtpk(y[d] * rs * sg[d], 0.f); yp[d * 16] = (bf16_t)(w & 0xffffu); } }
    }
    WAITBAR(0);
#undef WAITBAR
}

__device__ __forceinline__ void na_unit(int b, int h, int rb, const bf16_t* QB, const bf16_t* KB, const bf16_t* VB, bf16_t* Y, const float* rpb, char* lds) {
    const int tid = threadIdx.x, lane = tid & 63, r32 = lane & 31, hi = lane >> 5; const int wid = __builtin_amdgcn_readfirstlane(tid >> 6);
    float* ws = (float*)(lds + LDS_WS) + wid * 64; float* bias = (float*)(lds + LDS_BIAS);
    if (tid < 15 * 31) bias[(tid / 31) * 128 + 48 + tid % 31] = rpb[h * 465 + tid] * LOG2E;
    const int R0 = rb * 4, rq = R0 + (wid >> 1), half = wid & 1, qc = half * 32 + r32;
    const int cs = min(max(qc - 8, 0), GRIDW - 16);
    const int rs0 = min(max(rq - 4, 0), GROWS - 8);
    const int krlo = min(max(R0 - 4, 0), GROWS - 8), krhi = min(max(R0 + 3 - 4, 0), GROWS - 8) + 7;
    int nlat = krhi - krlo + 1; const int NT = 4 + nlat;
    const size_t qrow0 = (size_t)b * SEQ + (size_t)R0 * 64 + wid * 32;
    bf16x8 qr[8];
    { const bf16_t* Qw = QB + (qrow0 + r32) * LDR + h * 128 + hi * 8;
#pragma unroll
      for (int d0 = 0; d0 < 8; ++d0) qr[d0] = *reinterpret_cast<const bf16x8*>(Qw + d0 * 16); }
    const bf16_t* Kc = KB + ((size_t)MTOK + (size_t)b * CTXL) * LDR + h * 128; const bf16_t* Kl = KB + ((size_t)b * SEQ + (size_t)krlo * 64) * LDR + h * 128;
    const bf16_t* Vc = VB + ((size_t)MTOK + (size_t)b * CTXL) * LDR + h * 128; const bf16_t* Vl = VB + ((size_t)b * SEQ + (size_t)krlo * 64) * LDR + h * 128;
    Stager st; st.init(tid);
    const int vb0 = (int)(uintptr_t)lds + v_rd_base(lane);
    f32x16 o[4];
#pragma unroll
    for (int d = 0; d < 4; ++d) o[d] = f32x16{};
    float l = 0.f;
    st.load(Kc, Vc); asm volatile("s_waitcnt vmcnt(0)" ::: "memory"); st.write(lds, 0); __syncthreads();
    for (int j = 0; j < NT; ++j) {
        const int cur = j & 1;
        if (j + 1 < NT) { const int t = j + 1; if (t < 4) st.load(Kc + (size_t)t * 64 * LDR, Vc + (size_t)t * 64 * LDR); else st.load(Kl + (size_t)(t - 4) * 64 * LDR, Vl + (size_t)(t - 4) * 64 * LDR); }
        const int kr = krlo + j - 4;
        const bool active = (j < 4) || (kr >= rs0 && kr <= rs0 + 7);
        if (active) {
            const char* Ks = lds + 2 * SHM_V + cur * SHM_K; const int vb = vb0 + cur * SHM_V;
            f32x16 p0, p1; bf16x8 pa0, pa1, pa2, pa3;
            qkt<0, 8>(p0, p1, Ks, qr, r32, hi);
            if (j >= 4) {
                const float* brow = bias + (kr - rq + 7) * 128 + 48 + (15 - qc + 4 * hi); const int dc = 4 * hi - cs;
#pragma unroll
                for (int r = 0; r < 16; ++r) { const int c0 = (r & 3) + 8 * (r >> 2);
                    const float s0 = p0[r] + brow[c0], s1 = p1[r] + brow[c0 + 32];
                    p0[r] = ((unsigned)(c0 + dc) < 16u) ? __builtin_amdgcn_exp2f(s0) : 0.f;
                    p1[r] = ((unsigned)(c0 + 32 + dc) < 16u) ? __builtin_amdgcn_exp2f(s1) : 0.f;
                    if ((r & 3) == 3) SBAR(); }
            } else {
#pragma unroll
                for (int r = 0; r < 16; ++r) { p0[r] = __builtin_amdgcn_exp2f(p0[r]); p1[r] = __builtin_amdgcn_exp2f(p1[r]); }
            }
            { float ps = 0.f;
#pragma unroll
              for (int r = 0; r < 16; ++r) ps += p0[r] + p1[r];
              l += ps; }
            pack_p(p0, p1, pa0, pa1, pa2, pa3); SBAR();
            pv_d0(o, vb, pa0, pa1, pa2, pa3);
        }
        if (j + 1 < NT) { asm volatile("s_waitcnt vmcnt(0)" ::: "memory"); st.write(lds, cur ^ 1); }
        __syncthreads();
    }
    l = half_sum(l);
    if (hi == 0) ws[r32] = l; asm volatile("s_waitcnt lgkmcnt(0)" ::: "memory");
#pragma unroll
    for (int r = 0; r < 16; ++r) { const int orow = crow(r, hi); const float il = __builtin_amdgcn_rcpf(ws[orow]);
        bf16_t* yp = Y + (qrow0 + orow) * DM + 1024 + h * 128 + r32;
#pragma unroll
        for (int d = 0; d < 4; ++d) { const unsigned w = cvtpk(o[d][r] * il, 0.f); yp[d * 32] = (bf16_t)(w & 0xffffu); } }
    __syncthreads();
}
#undef KSWZ
#undef SBAR
}

constexpr int NWAVES = 8;
constexpr int N_LAUNCHES = MK_N_LAUNCHES;
constexpr int PER_PHASE = 13;
static_assert(N_LAUNCHES == 1 || N_LAUNCHES == PER_PHASE, "MK_N_LAUNCHES is 1 or 13");

constexpr size_t MiB = 1u << 20;
constexpr size_t WS_CTL = 0, CTL_ZERO_BYTES = 1 * MiB;
constexpr size_t WS_MOD = 1 * MiB;
constexpr size_t WS_GAINS = 1 * MiB + 384 * 1024;
constexpr size_t WS_ROPE = 1 * MiB + 512 * 1024;
constexpr size_t WS_WIN = 2 * MiB, WS_WAB = 42 * MiB, WS_WO = 50 * MiB, WS_WGU = 58 * MiB, WS_WD = 314 * MiB;
constexpr size_t WS_ROWSQ = 442 * MiB;
constexpr size_t WS_AFF = 446 * MiB;
constexpr size_t WS_TOK = 448 * MiB;
constexpr size_t WS_GSEL = WS_TOK + 256 * 1024;
constexpr size_t WS_INV = 449 * MiB;
constexpr size_t WS_H = 452 * MiB;
constexpr size_t WS_PB = 584 * MiB, PB_STRIDE = 66 * MiB;
constexpr size_t WS_GATE = 980 * MiB;
constexpr size_t WS_U = WS_PB;
constexpr size_t WS_XE = WS_PB + 2 * PB_STRIDE;
constexpr size_t WS_END = 1236 * MiB;
static_assert(WS_H + (size_t)MALL * DM * 2 <= WS_PB && WS_PB + 6 * PB_STRIDE <= WS_GATE && WS_GATE + (size_t)MTOK * 4096 * 2 <= WS_END, "d_ws map");
static_assert(WS_U + (size_t)MTOK * UP * 2 <= WS_XE && WS_XE + (size_t)MSLOT * DM * 2 <= WS_GATE && (size_t)MALL * 1024 * 2 <= PB_STRIDE, "d_ws overlays");
static_assert(WS_WD + (size_t)NE * DM * FF * 2 <= WS_ROWSQ && WS_INV + (size_t)MTOK * 16 * 4 <= WS_H, "d_ws map 2");
constexpr int CW_TMO = 0, CW_CODE = 1, CW_BAR = 4096;

constexpr int RING_OFF = 0, RING_BYTES = 131072;
constexpr int LDSCTL_OFF = RING_BYTES, MISC_OFF = LDSCTL_OFF + 320;
constexpr int LDS_BYTES = 147456;
constexpr int EPI_X_OFF = 136192;
static_assert(EPI_X_OFF >= att::LDS_ATT_BYTES && EPI_X_OFF + 8192 <= LDS_BYTES, "LDS map: epilogue exchange table");
static_assert(MISC_OFF + 128 <= att::LDS_WS && att::LDS_ATT_BYTES <= LDS_BYTES && att::NSLOT * att::SLOT <= RING_BYTES, "LDS map");

#define GAS __attribute__((address_space(1)))
#define LAS __attribute__((address_space(3)))
typedef unsigned short bf16;
typedef unsigned v4u __attribute__((ext_vector_type(4)));
typedef unsigned v2u __attribute__((ext_vector_type(2)));
typedef float f32x4 __attribute__((ext_vector_type(4)));
typedef GAS unsigned gu32;
#define RLX_AGENT __ATOMIC_RELAXED, __HIP_MEMORY_SCOPE_AGENT
#define LDS_WAIT() asm volatile("s_waitcnt lgkmcnt(0)" ::: "memory")
#define VM_WAIT() asm volatile("s_waitcnt vmcnt(0)" ::: "memory")
__device__ __forceinline__ unsigned f2bf(float f) { unsigned u = __builtin_bit_cast(unsigned, f); return (u + 0x7fffu + ((u >> 16) & 1u)) >> 16; }
__device__ __forceinline__ unsigned pk2(float lo, float hi) { return f2bf(lo) | (f2bf(hi) << 16); }
__device__ __forceinline__ float bflo(unsigned w) { return __uint_as_float(w << 16); }
__device__ __forceinline__ float bfhi(unsigned w) { return __uint_as_float(w & 0xffff0000u); }

#define XB_TMO      128
#define XB_XCNT(j)  (256  + 64 * (j))
#define XB_XSUB(j)  (1280 + 64 * (j))
#define XB_XGEN(j)  (2304 + 64 * (j))
#define XB_TOP      3328
#define XB_TOPGEN   3392
#define XCD_BAR_WORDS 3456
#define XB_SPIN_CAP (1u << 18)

__device__ __forceinline__ unsigned xb_ld(unsigned* p)              { return __hip_atomic_load(p, __ATOMIC_RELAXED, __HIP_MEMORY_SCOPE_AGENT); }
__device__ __forceinline__ unsigned xb_add(unsigned* p, unsigned v) { return __hip_atomic_fetch_add(p, v, __ATOMIC_RELAXED, __HIP_MEMORY_SCOPE_AGENT); }
__device__ __forceinline__ unsigned xb_xcc_id() { return (unsigned)__builtin_amdgcn_s_getreg((3 << 11) | 20) & 0xFu; }
#define XB_SPIN(cond, bar) do { unsigned _sp = 0; while (cond) { __builtin_amdgcn_s_sleep(1); \
    if ((++_sp & 255u) == 0u) { if (xb_ld(&(bar)[XB_TMO])) break; if (_sp > XB_SPIN_CAP) { atomicAdd(&(bar)[XB_TMO], 1u); break; } } } } while (0)

struct XcdBarrier {
    unsigned* bar; unsigned x;
    volatile LAS unsigned* st;
};

__device__ __forceinline__ XcdBarrier xcd_barrier_post(unsigned* bar, volatile LAS unsigned* st) {
    XcdBarrier b; b.bar = bar; b.x = xb_xcc_id(); b.st = st;
    if (threadIdx.x == 0) (void)xb_add(&bar[XB_XCNT(b.x)], 1u);
    return b;
}
__device__ __forceinline__ void xcd_barrier_complete(unsigned* bar, unsigned x, unsigned& nloc, unsigned& nx) {
    const unsigned G = gridDim.x * gridDim.y * gridDim.z;
    unsigned sum, cnt, mine, sp = 0u;
    for (;;) {
        sum = 0u; cnt = 0u; mine = 0u;
#pragma unroll
        for (unsigned j = 0; j < 16; ++j) { const unsigned c = xb_ld(&bar[XB_XCNT(j)]); sum += c; cnt += (c > 0u) ? 1u : 0u; mine = (j == x) ? c : mine; }
        if (sum == G) break;
        __builtin_amdgcn_s_sleep(1);
        if ((++sp & 255u) == 0u) { if (xb_ld(&bar[XB_TMO])) break; if (sp > XB_SPIN_CAP) { atomicAdd(&bar[XB_TMO], 1u); break; } }
    }
    nloc = mine > 0u ? mine : 1u; nx = cnt > 0u ? cnt : 1u;
}

__device__ __forceinline__ void xcd_barrier(const XcdBarrier& b) {
    asm volatile("s_waitcnt vmcnt(0)" ::: "memory");
    __syncthreads();
    if (threadIdx.x == 0) {
        unsigned* bar = b.bar;
        __builtin_amdgcn_s_waitcnt(0);
        unsigned nloc = b.st[0], nx = b.st[1];
        if (nloc == 0u) { xcd_barrier_complete(bar, b.x, nloc, nx); b.st[0] = nloc; b.st[1] = nx; }
        const unsigned old = xb_add(&bar[XB_XSUB(b.x)], 1u);
        const unsigned gen = old / nloc;
        if (old + 1u == (gen + 1u) * nloc) {
            __builtin_amdgcn_fence(__ATOMIC_RELEASE, "agent");
            asm volatile("s_waitcnt vmcnt(0)" ::: "memory");
            const unsigned og = xb_add(&bar[XB_TOP], 1u);
            const unsigned tg = og / nx;
            if (og + 1u == (tg + 1u) * nx) xb_add(&bar[XB_TOPGEN], 1u);
            else XB_SPIN(xb_ld(&bar[XB_TOPGEN]) == tg, bar);
            __builtin_amdgcn_fence(__ATOMIC_ACQUIRE, "agent");
            xb_add(&bar[XB_XGEN(b.x)], 1u);
            asm volatile("s_waitcnt vmcnt(0)" ::: "memory");
        } else {
            XB_SPIN(xb_ld(&bar[XB_XGEN(b.x)]) == gen, bar);
            __builtin_amdgcn_fence(__ATOMIC_ACQUIRE, "agent");
            asm volatile("s_waitcnt vmcnt(0)" ::: "memory");
        }
    }
    __syncthreads();
}

struct Frame {
    LAS unsigned char* lds;
    volatile LAS unsigned* MISC;
    gu32* ctl;
    int wave;
    int vcu, G;
};
struct Args {
    const float* in[26]; float* out; unsigned char* ws; int ph_lo, ph_hi, li, pad;
};
enum InIdx { I_X = 0, I_C, I_CTX, I_CCTX, I_WMOD, I_BMOD, I_G1, I_G2, I_WIN, I_QGA, I_KGA, I_LQ1, I_LK1, I_LQ2, I_LK2, I_SUBLN, I_QGB, I_KGB, I_RPB, I_WA, I_WB, I_WOUT, I_WR, I_WEG, I_WEU, I_WED };

__device__ __forceinline__ int ph_tid() { int t = threadIdx.x; asm volatile("" : "+v"(t)); return t; }
__device__ __forceinline__ float wave_sum(float v) {
#pragma unroll
    for (int o = 1; o < 64; o <<= 1) v += __shfl_xor(v, o);
    return v;
}
__device__ __forceinline__ float silu_f(float v) { return v / (1.0f + __expf(-v)); }

__device__ __forceinline__ void p0_mod(Frame& F, const Args& a, float* mod) {
    const int tid = ph_tid(), lane = tid & 63; (void)lane;
    LAS float* sv = (LAS float*)(F.lds + RING_OFF);
    LAS float* red = (LAS float*)(F.lds + RING_OFF + 40960);
    const float* c = a.in[I_C]; const float* cctx = a.in[I_CCTX]; const float* wmod = a.in[I_WMOD]; const float* bmod = a.in[I_BMOD];
    for (int i = tid; i < 5 * DM; i += NWAVES * 64) { const int r = i / DM, k = i % DM; sv[i] = silu_f(r < 4 ? c[r * DM + k] : cctx[k]); }
    __syncthreads();
    for (int s = blockIdx.x; s < 256; s += F.G) {
        const int cg = tid % 12, kl = tid / 12;
        float acc[5][4];
#pragma unroll
        for (int r = 0; r < 5; ++r)
#pragma unroll
            for (int e = 0; e < 4; ++e) acc[r][e] = 0.f;
        if (kl < 42) {
            for (int k = kl; k < DM; k += 42) { const f32x4 w = *(const f32x4*)(wmod + (size_t)k * 12288 + 48 * s + 4 * cg);
#pragma unroll
                for (int r = 0; r < 5; ++r) { const float sk = sv[r * DM + k];
#pragma unroll
                    for (int e = 0; e < 4; ++e) acc[r][e] += sk * w[e]; } }
#pragma unroll
            for (int r = 0; r < 5; ++r)
#pragma unroll
                for (int e = 0; e < 4; ++e) red[(kl * 12 + cg) * 20 + r * 4 + e] = acc[r][e];
        }
        __syncthreads();
        if (tid < 240) { const int r = tid / 48, col = tid % 48, g = col >> 2, e = col & 3; float t = 0.f;
            for (int q = 0; q < 42; ++q) t += red[(q * 12 + g) * 20 + r * 4 + e];
            mod[(size_t)r * 12288 + 48 * s + col] = t + bmod[48 * s + col]; }
        __syncthreads();
    }
}
__device__ __forceinline__ size_t b_tile_off(int drow, int k, int ntk, bool perm) {
    const int pn = drow >> 8, nl = drow & 255, h = nl >> 7, r = nl & 127, w = r & 31;
    const int rho = perm ? (r & ~31) + (16 * ((w >> 2) & 1) + 4 * (w >> 3) + (w & 3)) : r;
    return ((((size_t)pn * ntk + (k >> 6)) * 2 + h) * 16384 + (size_t)pg8::lds_byte(rho, k & 63)) >> 1;
}
__device__ __forceinline__ void p0_transpose_item(const float* W, int ldw, int k0, int n0, bf16* WT, int ldt, int drow0, int kdst0, LAS float* scr, int lane, bool perm) {
#pragma unroll 8
    for (int i = 0; i < 32; ++i) { const int kk = 2 * i + (lane >> 5); scr[kk * 33 + (lane & 31)] = W[(size_t)(k0 + kk) * ldw + n0 + (lane & 31)]; }
    LDS_WAIT(); asm volatile("" ::: "memory");
    const int c = lane & 7;
#pragma unroll
    for (int j = 0; j < 4; ++j) { const int n = (lane >> 3) + 8 * j; const LAS float* s = scr + (8 * c) * 33 + n;
        v4u o; o.x = pk2(s[0 * 33], s[1 * 33]); o.y = pk2(s[2 * 33], s[3 * 33]); o.z = pk2(s[4 * 33], s[5 * 33]); o.w = pk2(s[6 * 33], s[7 * 33]);
        *(GAS v4u*)(WT + b_tile_off(drow0 + n, kdst0 + k0 + 8 * c, ldt >> 6, perm)) = o; }
    LDS_WAIT(); asm volatile("" ::: "memory");
}
__device__ __forceinline__ void p0_expert_item(const Args& a, int r, LAS float* scr, int lane) {
    constexpr int I_E = 32 * 64;
    bf16* Wgu = (bf16*)(a.ws + WS_WGU); bf16* Wd = (bf16*)(a.ws + WS_WD);
    const int which = r / (NE * I_E); r -= which * (NE * I_E);
    const int e = r / I_E; r -= e * I_E; const int kb = r / 64, nb = r % 64, n0 = 32 * nb;
    if (which == 0)      p0_transpose_item(a.in[I_WEG] + (size_t)e * DM * FF, FF, 64 * kb, n0, Wgu + (size_t)e * 2 * FF * DM, DM, 256 * (n0 >> 7) + (n0 & 127), 0, scr, lane, true);
    else if (which == 1) p0_transpose_item(a.in[I_WEU] + (size_t)e * DM * FF, FF, 64 * kb, n0, Wgu + (size_t)e * 2 * FF * DM, DM, 256 * (n0 >> 7) + 128 + (n0 & 127), 0, scr, lane, true);
    else                 p0_transpose_item(a.in[I_WED] + (size_t)e * FF * DM, DM, 64 * kb, n0, Wd + (size_t)e * DM * FF, FF, n0, 0, scr, lane, true);
}
constexpr int X_ITEMS = 3 * NE * 32 * 64, XE0 = X_ITEMS - 36864, XE1 = X_ITEMS - 12288;
__device__ __forceinline__ void p0_expert_range(Frame& F, const Args& a, int lo, int hi, int w, int nw) {
    const int tid = ph_tid(), lane = tid & 63; (void)lane;
    LAS float* scr = (LAS float*)(F.lds + RING_OFF + F.wave * 16384);
    for (int r = lo + w; r < hi; r += nw) p0_expert_item(a, r, scr, lane);
}
__device__ __forceinline__ void p0_weights(Frame& F, const Args& a) {
    const int tid = ph_tid(), lane = tid & 63; (void)lane;
    LAS float* scr = (LAS float*)(F.lds + RING_OFF + F.wave * 16384);
    const int gw = F.vcu * NWAVES + F.wave, NGW = F.G * NWAVES;
    bf16* Win = (bf16*)(a.ws + WS_WIN); bf16* Wab = (bf16*)(a.ws + WS_WAB); bf16* Wo = (bf16*)(a.ws + WS_WO);
    constexpr int I_IN = 32 * 320, I_A = 16 * 64, I_O = 32 * 64;
    constexpr int NX = I_IN + 2 * I_A + I_O;
    const int nitems = NX + (F.G == 256 ? XE0 : X_ITEMS);
    for (int it = gw; it < nitems; it += NGW) {
        int r = it;
        if (r < I_IN) { const int kb = r / 320, nb = r % 320; int dr = 32 * nb;
            if (dr >= 2048 && dr < 6144) { const int isb = dr >= 4096 ? 1 : 0, c = dr - 2048 - 2048 * isb; dr = 2048 + 256 * (c >> 7) + 128 * isb + (c & 127); }
            p0_transpose_item(a.in[I_WIN], PROJ, 64 * kb, 32 * nb, Win, DM, dr, 0, scr, lane, true); continue; } r -= I_IN;
        if (r < I_A) { const int kb = r / 64, nb = r % 64; p0_transpose_item(a.in[I_WA], DM, 64 * kb, 32 * nb, Wab, DM, 32 * nb, 0, scr, lane, true); continue; } r -= I_A;
        if (r < I_A) { const int kb = r / 64, nb = r % 64; p0_transpose_item(a.in[I_WB], DM, 64 * kb, 32 * nb, Wab, DM, 32 * nb, 1024, scr, lane, true); continue; } r -= I_A;
        if (r < I_O) { const int kb = r / 64, nb = r % 64; p0_transpose_item(a.in[I_WOUT], DM, 64 * kb, 32 * nb, Wo, DM, 32 * nb, 0, scr, lane, false); continue; } r -= I_O;
        p0_expert_item(a, r, scr, lane);
    }
}
__device__ __forceinline__ void p1_norm1(Frame& F, const Args& a) {
    const int tid = ph_tid(), lane = tid & 63; (void)lane;
    const int gw = F.vcu * NWAVES + F.wave, NGW = F.G * NWAVES;
    const float* mod = (const float*)(a.ws + WS_MOD); const float* g1 = a.in[I_G1]; bf16* H = (bf16*)(a.ws + WS_H);
#define P1_XROW(m) ((const GAS f32x4*)((m) < MTOK ? a.in[I_X] + (size_t)(m) * DM : a.in[I_CTX] + (size_t)((m) - MTOK) * DM) + lane)
    f32x4 v[8];
    { const GAS f32x4* xr = P1_XROW(gw < MALL ? gw : 0);
#pragma unroll
      for (int j = 0; j < 8; ++j) v[j] = xr[64 * j]; }
    for (int m = gw; m < MALL; m += NGW) {
        const float* mr = mod + (size_t)(m < MTOK ? m / SEQ : 4) * 12288;
        f32x4 g[8], sh[8], sc[8], vn[8];
#pragma unroll
        for (int j = 0; j < 8; ++j) { const int c0 = 4 * lane + 256 * j; g[j] = *(const f32x4*)(g1 + c0); sh[j] = *(const f32x4*)(mr + c0); sc[j] = *(const f32x4*)(mr + 2048 + c0); }
        { const int mn = m + NGW; const GAS f32x4* xr = P1_XROW(mn < MALL ? mn : m);
#pragma unroll
          for (int j = 0; j < 8; ++j) vn[j] = xr[64 * j]; }
        __builtin_amdgcn_sched_barrier(0);
        float s = 0.f;
#pragma unroll
        for (int j = 0; j < 8; ++j) s += (v[j].x * v[j].x + v[j].y * v[j].y) + (v[j].z * v[j].z + v[j].w * v[j].w);
        const float rstd = 1.0f / sqrtf(wave_sum(s) * (1.0f / DM) + EPS);
        GAS v2u* o8 = (GAS v2u*)(H + (size_t)m * DM) + lane;
#pragma unroll
        for (int j = 0; j < 8; ++j) { const f32x4 y = (v[j] * rstd * g[j]) * (sc[j] + 1.0f) + sh[j];
            v2u w; w.x = pk2(y.x, y.y); w.y = pk2(y.z, y.w); o8[64 * j] = w; }
#pragma unroll
        for (int j = 0; j < 8; ++j) v[j] = vn[j];
    }
#undef P1_XROW
}
__device__ __forceinline__ void p3_qknorm(Frame& F, const Args& a) {
    const int tid = ph_tid(), lane = tid & 63; (void)lane;
    LAS float* tab = (LAS float*)(F.lds + RING_OFF);
    for (int i = tid; i < 128 * 16; i += NWAVES * 64) { const int p = i >> 4, f = i & 15; const float inv = exp2f(-(float)f * (13.287712379549449f / 16.0f));
        const float ang = (float)p * inv; tab[2 * i] = cosf(ang); tab[2 * i + 1] = sinf(ang); }
    __syncthreads();
    const int gw = F.vcu * NWAVES + F.wave, NGW = F.G * NWAVES;
    constexpr int NITEM = 2 * MTOK + 2 * MALL;
    for (int it = gw; it < NITEM; it += NGW) {
        int which, row;
        if (it < MTOK) { which = 0; row = it; } else if (it < 2 * MTOK) { which = 1; row = it - MTOK; } else if (it < 2 * MTOK + MALL) { which = 2; row = it - 2 * MTOK; } else { which = 3; row = it - 2 * MTOK - MALL; }
        if (which == 1 || which == 3) continue;
        const int bufi = which == 0 ? 0 : which == 1 ? 1 : which == 2 ? 2 : 4;
        bf16* p = (bf16*)(a.ws + WS_PB + (size_t)bufi * PB_STRIDE) + (size_t)row * 1024 + 16 * lane;
        const v4u w0 = *(const GAS v4u*)p, w1 = *(const GAS v4u*)(p + 8);
        float v[16];
        v[0] = bflo(w0.x); v[1] = bfhi(w0.x); v[2] = bflo(w0.y); v[3] = bfhi(w0.y); v[4] = bflo(w0.z); v[5] = bfhi(w0.z); v[6] = bflo(w0.w); v[7] = bfhi(w0.w);
        v[8] = bflo(w1.x); v[9] = bfhi(w1.x); v[10] = bflo(w1.y); v[11] = bfhi(w1.y); v[12] = bflo(w1.z); v[13] = bfhi(w1.z); v[14] = bflo(w1.w); v[15] = bfhi(w1.w);
        float ss = 0.f;
#pragma unroll
        for (int i = 0; i < 16; ++i) ss += v[i] * v[i];
        const bool isA = (which == 0 || which == 2);
        ss += __shfl_xor(ss, 1); ss += __shfl_xor(ss, 2);
        float rstd;
        if (isA) rstd = 1.0f / sqrtf(ss * (1.0f / 64.0f) + EPS);
        else { ss += __shfl_xor(ss, 4); rstd = 1.0f / sqrtf(ss * (1.0f / 128.0f) + EPS); }
        const float* gain = a.in[which == 0 ? I_QGA : which == 1 ? I_QGB : which == 2 ? I_KGA : I_KGB] + 16 * (isA ? (lane & 3) : (lane & 7));
        const float qs = which == 0 ? 0.125f * LOG2E : which == 1 ? 0.08838834764831845f * LOG2E : 1.0f;
#pragma unroll
        for (int i = 0; i < 16; ++i) v[i] = v[i] * rstd * gain[i];
        if (isA && row < MTOK) {
            const int t = row % SEQ, j = lane & 3, pos = (j < 2) ? (t / GRIDW) : (t % GRIDW);
            const LAS float* tp = tab + pos * 32;
#pragma unroll
            for (int i = 0; i < 16; ++i) { const float other = __shfl_xor(v[i], 1); const float cs = tp[2 * i], sn = tp[2 * i + 1];
                v[i] = (j & 1) ? (v[i] * cs + other * sn) : (v[i] * cs - other * sn); }
        }
        v4u o0, o1;
        o0.x = pk2(v[0] * qs, v[1] * qs); o0.y = pk2(v[2] * qs, v[3] * qs); o0.z = pk2(v[4] * qs, v[5] * qs); o0.w = pk2(v[6] * qs, v[7] * qs);
        o1.x = pk2(v[8] * qs, v[9] * qs); o1.y = pk2(v[10] * qs, v[11] * qs); o1.z = pk2(v[12] * qs, v[13] * qs); o1.w = pk2(v[14] * qs, v[15] * qs);
        *(GAS v4u*)p = o0; *(GAS v4u*)(p + 8) = o1;
    }
    __syncthreads();
}
__device__ __forceinline__ void p7_norm2_router(Frame& F, const Args& a) {
    const int tid = ph_tid(), lane = tid & 63; (void)lane;
    typedef float f4 __attribute__((ext_vector_type(4)));
    const int gw = F.vcu * NWAVES + F.wave, NGW = F.G * NWAVES, fr = lane & 15, fq = lane >> 4;
    const float* mod = (const float*)(a.ws + WS_MOD); const float* g2 = a.in[I_G2]; const float* wr = a.in[I_WR]; const float* xn = a.out;
    const float* rowsq = (const float*)(a.ws + WS_ROWSQ); bf16* H2 = (bf16*)(a.ws + WS_H); float* aff = (float*)(a.ws + WS_AFF);
    for (int tile = gw; tile < MTOK / 16; tile += NGW) {
        const int row = tile * 16 + fr, b = (tile * 16) / SEQ;
        const float* mr = mod + (size_t)b * 12288;
        float ss = 0.f;
#pragma unroll
        for (int q = 0; q < 8; ++q) { const f4 t = *(const f4*)(rowsq + (size_t)row * 32 + 4 * q); ss += t.x; ss += t.y; ss += t.z; ss += t.w; }
        const float rstd = 1.0f / sqrtf(ss * (1.0f / DM) + EPS);
        f4 acc = {0.f, 0.f, 0.f, 0.f};
        const float* xr = xn + (size_t)row * DM + 4 * fq; bf16* hr = H2 + (size_t)row * DM + 4 * fq;
        for (int k8 = 0; k8 < DM / 16; k8 += 8) { f4 xv[8], g[8], sh[8], sc[8]; float w0[8], w1[8], w2[8], w3[8];
#pragma unroll
            for (int q = 0; q < 8; ++q) { const int kk = k8 + q, c0 = 16 * kk + 4 * fq; xv[q] = *(const f4*)(xr + 16 * kk); g[q] = *(const f4*)(g2 + c0); sh[q] = *(const f4*)(mr + 6144 + c0); sc[q] = *(const f4*)(mr + 8192 + c0);
                const float* wp = wr + (size_t)c0 * 16 + fr; w0[q] = wp[0]; w1[q] = wp[16]; w2[q] = wp[32]; w3[q] = wp[48]; }
            __builtin_amdgcn_sched_barrier(0);
#pragma unroll
            for (int q = 0; q < 8; ++q) { const int kk = k8 + q;
                const f4 hv = (xv[q] * rstd * g[q]) * (sc[q] + 1.0f) + sh[q];
                v2u w; w.x = pk2(hv.x, hv.y); w.y = pk2(hv.z, hv.w); *(GAS v2u*)(hr + 16 * kk) = w;
                acc = __builtin_amdgcn_mfma_f32_16x16x4f32(hv.x, w0[q], acc, 0, 0, 0);
                acc = __builtin_amdgcn_mfma_f32_16x16x4f32(hv.y, w1[q], acc, 0, 0, 0);
                acc = __builtin_amdgcn_mfma_f32_16x16x4f32(hv.z, w2[q], acc, 0, 0, 0);
                acc = __builtin_amdgcn_mfma_f32_16x16x4f32(hv.w, w3[q], acc, 0, 0, 0); } }
        f4 pr;
#pragma unroll
        for (int r = 0; r < 4; ++r) { float mx = acc[r];
            mx = fmaxf(mx, __shfl_xor(mx, 1)); mx = fmaxf(mx, __shfl_xor(mx, 2)); mx = fmaxf(mx, __shfl_xor(mx, 4)); mx = fmaxf(mx, __shfl_xor(mx, 8));
            const float ex = __expf(acc[r] - mx); float sm = ex;
            sm += __shfl_xor(sm, 1); sm += __shfl_xor(sm, 2); sm += __shfl_xor(sm, 4); sm += __shfl_xor(sm, 8);
            pr[r] = ex / sm; }
        const int n0 = (tile * 16) % SEQ + 4 * fq;
        *(f4*)(aff + ((size_t)(b * NE + fr)) * SEQ + n0) = pr;
    }
}
__device__ __forceinline__ void p8_topk(Frame& F, const Args& a) {
    const int tid = ph_tid(), lane = tid & 63; (void)lane;
    LAS unsigned* key = (LAS unsigned*)(F.lds + RING_OFF);
    LAS unsigned* hist = (LAS unsigned*)(F.lds + RING_OFF + 32768);
    LAS unsigned* sel = (LAS unsigned*)(F.lds + RING_OFF + 32768 + 1024);
    LAS unsigned* wsum = (LAS unsigned*)(F.lds + RING_OFF + 32768 + 2048);
    const float* aff = (const float*)(a.ws + WS_AFF); int* tok = (int*)(a.ws + WS_TOK); float* gsel = (float*)(a.ws + WS_GSEL); int* inv = (int*)(a.ws + WS_INV);
    const int wave = F.wave;
    for (int p = blockIdx.x; p < NB * NE; p += F.G) {
        const int b = p / NE, e = p % NE;
        const unsigned* src = (const unsigned*)(aff + (size_t)p * SEQ);
        for (int i = tid; i < SEQ; i += NWAVES * 64) key[i] = src[i];
        unsigned prefix = 0u, mask = 0u, krem = CAP;
        for (int pass = 0; pass < 4; ++pass) {
            const int shift = 24 - 8 * pass;
            if (tid < 256) hist[tid] = 0u;
            __syncthreads();
            for (int i = tid; i < SEQ; i += NWAVES * 64) { const unsigned k = key[i]; if ((k & mask) == prefix) atomicAdd((unsigned*)&hist[(k >> shift) & 255u], 1u); }
            __syncthreads();
            if (wave == 0) {
                unsigned h0 = hist[255 - 4 * lane], h1 = hist[254 - 4 * lane], h2 = hist[253 - 4 * lane], h3 = hist[252 - 4 * lane];
                const unsigned s = h0 + h1 + h2 + h3; unsigned inc = s;
#pragma unroll
                for (int o = 1; o < 64; o <<= 1) { const unsigned t = __shfl_up(inc, o); if (lane >= o) inc += t; }
                const unsigned exc = inc - s;
                if (exc < krem && krem <= inc) {
                    unsigned r = krem - exc; int bin;
                    if (r <= h0) bin = 255 - 4 * lane; else { r -= h0; if (r <= h1) bin = 254 - 4 * lane; else { r -= h1; if (r <= h2) bin = 253 - 4 * lane; else { r -= h2; bin = 252 - 4 * lane; } } }
                    sel[0] = (unsigned)bin; sel[1] = r; }
            }
            __syncthreads();
            prefix |= sel[0] << shift; mask |= 255u << shift; krem = sel[1];
            __syncthreads();
        }
        const unsigned T = prefix;
        unsigned cgt = 0u, ceq = 0u; unsigned kk[16];
#pragma unroll
        for (int i = 0; i < 16; ++i) { kk[i] = key[16 * tid + i]; cgt += kk[i] > T ? 1u : 0u; ceq += kk[i] == T ? 1u : 0u; }
        const unsigned pk = cgt | (ceq << 16); unsigned inc = pk;
#pragma unroll
        for (int o = 1; o < 64; o <<= 1) { const unsigned t = __shfl_up(inc, o); if (lane >= o) inc += t; }
        if (lane == 63) wsum[wave] = inc;
        __syncthreads();
        unsigned base = 0u;
        for (int w = 0; w < wave; ++w) base += wsum[w];
        const unsigned exc = base + inc - pk; unsigned ngt = exc & 0xffffu, neq = exc >> 16;
#pragma unroll
        for (int i = 0; i < 16; ++i) { const int n = 16 * tid + i; int slot = -1;
            if (kk[i] > T) { slot = (int)(ngt + (neq < krem ? neq : krem)); ++ngt; }
            else if (kk[i] == T) { if (neq < krem) slot = (int)(ngt + neq); ++neq; }
            inv[((size_t)b * SEQ + n) * NE + e] = slot;
            if (slot >= 0) { tok[(size_t)p * CAP + slot] = b * SEQ + n; gsel[(size_t)p * CAP + slot] = __uint_as_float(kk[i]); } }
        __syncthreads();
    }
}
__device__ __forceinline__ void p9_gather(Frame& F, const Args& a) {
    const int tid = ph_tid(), lane = tid & 63; (void)lane;
    const int gw = F.vcu * NWAVES + F.wave, NGW = F.G * NWAVES;
    const int* tok = (const int*)(a.ws + WS_TOK); const bf16* H2 = (const bf16*)(a.ws + WS_H); bf16* XE = (bf16*)(a.ws + WS_XE);
    for (int s = gw; s < MSLOT; s += NGW) { int sv = s; asm volatile("" : "+v"(sv)); const int t = tok[sv];
        const GAS v4u* src = (const GAS v4u*)(H2 + (size_t)t * DM) + lane; GAS v4u* dst = (GAS v4u*)(XE + (size_t)s * DM) + lane;
        const v4u v0 = src[0], v1 = src[64], v2 = src[128], v3 = src[192]; dst[0] = v0; dst[64] = v1; dst[128] = v2; dst[192] = v3; }
}
__device__ __forceinline__ void p12_combine(Frame& F, const Args& a) {
    const int tid = ph_tid(), lane = tid & 63; (void)lane;
    const int gw = F.vcu * NWAVES + F.wave, NGW = F.G * NWAVES;
    const int* inv = (const int*)(a.ws + WS_INV); const bf16* YM = (const bf16*)(a.ws + WS_XE); float* out = a.out;
    int myslot = -1, nslot = -1; f32x4 acc[8];
    if (gw < MTOK) myslot = inv[(size_t)gw * NE + (lane & 15)];
    if (gw + NGW < MTOK) nslot = inv[(size_t)(gw + NGW) * NE + (lane & 15)];
    if (gw < MTOK && (__ballot(myslot >= 0) & 0xffffull) != 0ull) {
#pragma unroll
        for (int j = 0; j < 8; ++j) acc[j] = *(const GAS f32x4*)(out + (size_t)gw * DM + 4 * lane + 256 * j); }
    for (int m = gw; m < MTOK; m += NGW) {
        const int b = m / SEQ; const int mn = m + NGW, mnn = m + 2 * NGW;
        int nnslot = -1; if (mnn < MTOK) nnslot = inv[(size_t)mnn * NE + (lane & 15)];
        f32x4 accn[8];
        const bool nneed = (__ballot(nslot >= 0) & 0xffffull) != 0ull;
        if (nneed) {
#pragma unroll
            for (int j = 0; j < 8; ++j) accn[j] = *(const GAS f32x4*)(out + (size_t)mn * DM + 4 * lane + 256 * j); }
        __builtin_amdgcn_sched_barrier(0);
        unsigned mask = (unsigned)(__ballot(myslot >= 0) & 0xffffull);
        const bool need = mask != 0u;
        while (mask) {
            const int e1 = __builtin_ctz(mask); mask &= mask - 1; const bool two = mask != 0u; const int e2 = two ? __builtin_ctz(mask) : e1; if (two) mask &= mask - 1;
            const int s1 = __shfl(myslot, e1), s2 = __shfl(myslot, e2);
            const bf16* y1 = YM + ((size_t)(b * NE + e1) * CAP + s1) * DM + 4 * lane; const bf16* y2 = YM + ((size_t)(b * NE + e2) * CAP + s2) * DM + 4 * lane;
            v2u w1[8], w2[8];
#pragma unroll
            for (int j = 0; j < 8; ++j) { w1[j] = *(const GAS v2u*)(y1 + 256 * j); w2[j] = *(const GAS v2u*)(y2 + 256 * j); }
            __builtin_amdgcn_sched_barrier(0);
#pragma unroll
            for (int j = 0; j < 8; ++j) { acc[j].x += bflo(w1[j].x); acc[j].y += bfhi(w1[j].x); acc[j].z += bflo(w1[j].y); acc[j].w += bfhi(w1[j].y);
                if (two) { acc[j].x += bflo(w2[j].x); acc[j].y += bfhi(w2[j].x); acc[j].z += bflo(w2[j].y); acc[j].w += bfhi(w2[j].y); } }
        }
        if (need) {
#pragma unroll
            for (int j = 0; j < 8; ++j) *(GAS f32x4*)(out + (size_t)m * DM + 4 * lane + 256 * j) = acc[j]; }
        myslot = nslot; nslot = nnslot;
        if (nneed) {
#pragma unroll
            for (int j = 0; j < 8; ++j) acc[j] = accn[j]; }
    }
}

__global__ void __launch_bounds__(NWAVES * 64, 2) fwd_kernel(Args args) {
    extern __shared__ __attribute__((aligned(16))) unsigned char lds[];
    Frame F;
    F.lds = (LAS unsigned char*)lds;
    F.MISC = (volatile LAS unsigned*)(F.lds + MISC_OFF);
    F.wave = __builtin_amdgcn_readfirstlane(threadIdx.x >> 6);
    F.G = gridDim.x; { const int bx = blockIdx.x; F.vcu = (F.G % 8 == 0) ? (bx % 8) * (F.G / 8) + bx / 8 : bx; }
    unsigned char* ws = args.ws;
    F.ctl = (gu32*)(ws + WS_CTL);
    for (int u = threadIdx.x; u < (LDS_BYTES - LDSCTL_OFF) / 4; u += NWAVES * 64) ((LAS unsigned*)(F.lds + LDSCTL_OFF))[u] = 0u;
    __syncthreads();
    XcdBarrier bar; bar.bar = (unsigned*)(F.ctl + CW_BAR); bar.x = 0; bar.st = nullptr;
    if (N_LAUNCHES != PER_PHASE) bar = xcd_barrier_post((unsigned*)(F.ctl + CW_BAR), F.MISC + 8);
#define GRID_BAR(seam) do { if (N_LAUNCHES == PER_PHASE) { if (threadIdx.x == 0) __hip_atomic_store(F.ctl + CW_TMO, 0xBADBA0u | (unsigned)(seam), RLX_AGENT); } else { xcd_barrier(bar); } } while (0)
    const int lo = args.ph_lo, hi = args.ph_hi;
#ifdef ONLY_PHASE
#define IN(k) ((k) == ONLY_PHASE && lo <= (k) && (k) < hi)
#else
#define IN(k) (lo <= (k) && (k) < hi)
#endif
#define BOTH(k) (IN(k) && IN((k) + 1))
    float* mod = (float*)(ws + WS_MOD);
    bf16* PB = (bf16*)(ws + WS_PB); constexpr size_t PBS = PB_STRIDE / 2;

    if (IN(0)) {
        if (blockIdx.x == 0) { float* rt = (float*)(ws + WS_ROPE);
            for (int i = threadIdx.x; i < 128 * 16; i += NWAVES * 64) { const int p = i >> 4, f = i & 15; const float inv = exp2f(-(float)f * (13.287712379549449f / 16.0f));
                const float ang = (float)p * inv; rt[2 * i] = cosf(ang); rt[2 * i + 1] = sinf(ang); }
            float* gn = (float*)(ws + WS_GAINS);
            if (threadIdx.x < 64) { gn[threadIdx.x] = args.in[I_QGA][threadIdx.x]; gn[256 + threadIdx.x] = args.in[I_KGA][threadIdx.x]; }
            if (threadIdx.x < 128) { gn[128 + threadIdx.x] = args.in[I_QGB][threadIdx.x]; gn[384 + threadIdx.x] = args.in[I_KGB][threadIdx.x]; } }
        p0_mod(F, args, mod); p0_weights(F, args); if (BOTH(0)) GRID_BAR(0); }
    if (IN(1)) { p1_norm1(F, args); if (BOTH(1)) GRID_BAR(1); }
    if (IN(2)) {
        pg8::Gemm g{(const bf16*)(ws + WS_H), (const bf16*)(ws + WS_WIN), MALL, PROJ, DM}; pg8::ProjOrder S; S.init(F.G, (int)blockIdx.x);
        pg8::EpiProj E{PB, PBS, (bf16*)(ws + WS_GATE), (LAS float*)(F.lds + EPI_X_OFF), (const float*)(ws + WS_GAINS), (const float*)(ws + WS_ROPE)};
        pg8::gemm_phase<pg8::EpiProj, pg8::ProjOrder, true, true>(F.lds + RING_OFF, g, S, E);
        if (F.G == 256 && blockIdx.x >= 64) { __syncthreads(); p0_expert_range(F, args, XE0, XE1, ((int)blockIdx.x - 64) * NWAVES + F.wave, 192 * NWAVES); }
        if (BOTH(2)) GRID_BAR(2);
    }
#if !FUSE_A
    if (IN(3)) { p3_qknorm(F, args); if (BOTH(3)) GRID_BAR(3); }
#endif
    if (IN(4)) {
        float lam;
        { const float* q1 = args.in[I_LQ1]; const float* k1 = args.in[I_LK1]; const float* q2 = args.in[I_LQ2]; const float* k2 = args.in[I_LK2];
          const int lane = ph_tid() & 63; const float s1 = wave_sum(q1[lane] * k1[lane]), s2 = wave_sum(q2[lane] * k2[lane]); lam = expf(s1) - expf(s2) + 0.2f; }
        bf16* Y = (bf16*)(ws + WS_H);
        const int bx = blockIdx.x;
        if (F.G == 256) {
            const int x = bx & 7, j = bx >> 3;
#ifndef NO_DIFF
            for (int i = 0; i < 8; ++i) att::diff_unit((x * 4 + (i >> 1)) >> 3, (x * 4 + (i >> 1)) & 7, (i & 1) * 32 + j, PB, PB + 2 * PBS, PB + 3 * PBS, Y, lam, args.in[I_SUBLN], (char*)lds + RING_OFF, F.lds + RING_OFF);
#endif
#ifndef NO_NA
            for (int i = 0; i < 4; ++i) att::na_unit((x * 4 + i) >> 3, (x * 4 + i) & 7, j, PB + PBS, PB + 4 * PBS, PB + 5 * PBS, Y, args.in[I_RPB], (char*)lds + RING_OFF);
#endif
        } else {
#ifndef NO_DIFF
            for (int uu = bx; uu < 2048; uu += F.G) att::diff_unit((uu >> 6) >> 3, (uu >> 6) & 7, uu & 63, PB, PB + 2 * PBS, PB + 3 * PBS, Y, lam, args.in[I_SUBLN], (char*)lds + RING_OFF, F.lds + RING_OFF);
#endif
#ifndef NO_NA
            for (int uu = bx; uu < 1024; uu += F.G) att::na_unit((uu >> 5) >> 3, (uu >> 5) & 7, uu & 31, PB + PBS, PB + 4 * PBS, PB + 5 * PBS, Y, args.in[I_RPB], (char*)lds + RING_OFF);
#endif
        }
        if (BOTH(4)) GRID_BAR(4);
    }
    if (IN(5)) {
        pg8::Gemm g{(const bf16*)(ws + WS_H), (const bf16*)(ws + WS_WAB), MTOK, DM, DM}; pg8::StaticOrder S; S.init(MTOK, DM, F.G, (int)blockIdx.x);
        pg8::EpiMerge E{(const bf16*)(ws + WS_GATE), (bf16*)(ws + WS_U)};
        pg8::gemm_phase<pg8::EpiMerge, pg8::StaticOrder, true, true>(F.lds + RING_OFF, g, S, E);
        if (BOTH(5)) GRID_BAR(5);
    }
    if (IN(6)) {
        pg8::Gemm g{(const bf16*)(ws + WS_U), (const bf16*)(ws + WS_WO), MTOK, DM, DM, UP}; pg8::StaticOrder S; S.init(MTOK, DM, F.G, (int)blockIdx.x);
        if (F.G == 256) {
            pg8::EpiWoDrain Ed{args.in[I_X], mod, args.out, (float*)(ws + WS_ROWSQ)}; pg8::OneUnitOrder S1; S1.so = S;
            S1.which = 0; pg8::gemm_phase<pg8::EpiWoDrain, pg8::OneUnitOrder, false, true>(F.lds + RING_OFF, g, S1, Ed); __syncthreads();
            S1.which = 1; pg8::gemm_phase<pg8::EpiWoDrain, pg8::OneUnitOrder, false, true>(F.lds + RING_OFF, g, S1, Ed); __syncthreads();
            S1.which = 2; pg8::gemm_phase<pg8::EpiWoDrain, pg8::OneUnitOrder, false, true>(F.lds + RING_OFF, g, S1, Ed); __syncthreads();
            S1.which = 3; pg8::gemm_phase<pg8::EpiWoDrain, pg8::OneUnitOrder, false, true>(F.lds + RING_OFF, g, S1, Ed); __syncthreads();
        } else {
        pg8::EpiWo E{args.in[I_X], mod, args.out, (float*)(ws + WS_ROWSQ)};
        pg8::gemm_phase<pg8::EpiWo, pg8::StaticOrder, true, true>(F.lds + RING_OFF, g, S, E);
        }
        if (BOTH(6)) GRID_BAR(6);
    }
    if (IN(7)) { p7_norm2_router(F, args); if (BOTH(7)) GRID_BAR(7); }
    if (IN(8)) { p8_topk(F, args); if (F.G == 256 && blockIdx.x >= 64) p0_expert_range(F, args, XE1, X_ITEMS, ((int)blockIdx.x - 64) * NWAVES + F.wave, 192 * NWAVES); if (BOTH(8)) GRID_BAR(8); }
    if (IN(10)) {
        pg8::Gemm g{(const bf16*)(ws + WS_H), (const bf16*)(ws + WS_WGU), MSLOT, 2 * FF, DM}; pg8::ExpertGatherOrder S; S.init(MSLOT, 2 * FF, F.G, (int)blockIdx.x); S.estride = (size_t)2 * FF * DM * 2; S.rowmap = (const int*)(ws + WS_TOK);
        pg8::EpiSwiglu E{(bf16*)(ws + WS_GATE)};
        pg8::gemm_phase<pg8::EpiSwiglu, pg8::ExpertGatherOrder, true, true>(F.lds + RING_OFF, g, S, E);
        if (BOTH(10)) GRID_BAR(10);
    }
    if (IN(11)) {
        pg8::Gemm g{(const bf16*)(ws + WS_GATE), (const bf16*)(ws + WS_WD), MSLOT, DM, FF}; pg8::ExpertOrder S; S.init(MSLOT, DM, F.G, (int)blockIdx.x); S.estride = (size_t)DM * FF * 2;
        pg8::EpiDown E{(const float*)(ws + WS_GSEL), mod, (bf16*)(ws + WS_XE)};
        pg8::gemm_phase<pg8::EpiDown, pg8::ExpertOrder, true, true>(F.lds + RING_OFF, g, S, E);
        if (BOTH(11)) GRID_BAR(11);
    }
    if (IN(12)) { p12_combine(F, args); }
#undef IN
#undef BOTH
}

extern "C" void kernel_launch(void* const* d_in, const int* in_sizes, int n_in, void* d_out, int out_size, void* d_ws, size_t ws_size, hipStream_t stream) {
    static int grid = 0;
    if (grid == 0) {
        if (n_in != 26 || in_sizes[0] != MTOK * DM || out_size != MTOK * DM || ws_size < WS_END) { fprintf(stderr, "kernel_launch: shape mismatch: n_in %d in0 %d out %d ws %zu (need %zu); nothing launched\n", n_in, n_in > 0 ? in_sizes[0] : -1, out_size, ws_size, (size_t)WS_END); grid = -1; return; }
        int dev = 0, cus = 0, per_cu = 0;
        if (hipGetDevice(&dev) != hipSuccess || hipDeviceGetAttribute(&cus, hipDeviceAttributeMultiprocessorCount, dev) != hipSuccess) { fprintf(stderr, "kernel_launch: device query failed\n"); grid = -1; return; }
        if (hipFuncSetAttribute((const void*)fwd_kernel, hipFuncAttributeMaxDynamicSharedMemorySize, LDS_BYTES) != hipSuccess) { fprintf(stderr, "kernel_launch: hipFuncSetAttribute failed\n"); grid = -1; return; }
        if (hipOccupancyMaxActiveBlocksPerMultiprocessor(&per_cu, (const void*)fwd_kernel, NWAVES * 64, LDS_BYTES) != hipSuccess || per_cu < 1)
            fprintf(stderr, "kernel_launch: note: occupancy query reports %d workgroups per CU\n", per_cu);
        (void)hipGetLastError();
        grid = cus;
    }
    if (grid < 0) return;
    if (hipMemsetAsync((char*)d_ws + WS_CTL, 0, CTL_ZERO_BYTES, stream) != hipSuccess) { fprintf(stderr, "kernel_launch: memset failed\n"); return; }
    Args a{};
    for (int i = 0; i < 26; ++i) a.in[i] = (const float*)d_in[i];
    a.out = (float*)d_out; a.ws = (unsigned char*)d_ws; a.pad = 0;
    for (int li = 0; li < N_LAUNCHES; ++li) {
        a.ph_lo = (N_LAUNCHES == PER_PHASE) ? li : 0; a.ph_hi = (N_LAUNCHES == PER_PHASE) ? li + 1 : PER_PHASE; a.li = li;
        hipLaunchKernelGGL(fwd_kernel, dim3(grid), dim3(NWAVES * 64), LDS_BYTES, stream, a);
        const hipError_t le = hipPeekAtLastError();
        if (le != hipSuccess) { fprintf(stderr, "kernel_launch: launch %d failed: %s\n", li, hipGetErrorName(le)); break; }
    }
}
```
